# Optimizing an MI355X kernel written in HIP

```python
import jax, jax.numpy as jnp
from jax import lax
import numpy as np

D_MODEL = 2048
BATCH = 4
SEQ = 2048
DEPTH = 2
DEC_BATCH = 32
DEC_SEQ = 8
PAST_LEN = 16384
PAGE_SIZE = 128

N_MEM = 256
MEM_HEADS = 4
MEM_WIDTH = D_MODEL // 4
MEM_HEAD_DIM = MEM_WIDTH // MEM_HEADS
TOKEN_WIDTH = D_MODEL - MEM_WIDTH
CONV_WIDTH = 3
WINDOW = 128
HEAD_DIM = 64
N_HEADS = TOKEN_WIDTH // HEAD_DIM
N_KV_HEADS = 4
GROUP = N_HEADS // N_KV_HEADS
KV_WIDTH = N_KV_HEADS * HEAD_DIM
D_FF = ((8 * D_MODEL + 3 * 256 - 1) // (3 * 256)) * 256
N_CONV_LAYERS = (DEPTH + 1) // 2
N_ATTN_LAYERS = DEPTH // 2
EPS = 1e-6

kernel_name = "hybrid_conv_swa_sink_memxattn_decoder_step"


def rmsnorm(x, g):
    xf = x.astype(jnp.float32)
    r = lax.rsqrt(jnp.mean(xf * xf, axis=-1, keepdims=True) + EPS)
    return (xf * r).astype(x.dtype) * g


def swiglu(h, w_gate, w_up, w_down):
    return (jax.nn.silu(h @ w_gate) * (h @ w_up)) @ w_down


def cross_attention(qm, mk, mv):
    n, t = qm.shape[:2]
    q = qm.reshape(n, t, MEM_HEADS, MEM_HEAD_DIM)
    s = jnp.einsum('nqhd,nmhd->nhqm', q, mk).astype(jnp.float32) * (MEM_HEAD_DIM ** -0.5)
    p = jax.nn.softmax(s, axis=-1).astype(mv.dtype)
    o = jnp.einsum('nhqm,nmhd->nqhd', p, mv)
    return o.reshape(n, t, MEM_WIDTH)


def band_attention(q, kk, vv, sinks, key_valid):
    n, nq = q.shape[:2]
    nk = kk.shape[1]
    qg = q.reshape(n, nq, N_KV_HEADS, GROUP, HEAD_DIM)
    s = jnp.einsum('nqkgd,njkd->nkgqj', qg, kk).astype(jnp.float32) * (HEAD_DIM ** -0.5)
    qi = jnp.arange(nq)[:, None]
    kj = jnp.arange(nk)[None, :]
    band = (kj > qi) & (kj <= qi + WINDOW)
    mask = band[None, None, None] & key_valid[:, None, None, None, :]
    s = jnp.where(mask, s, -jnp.inf)
    sink = sinks.astype(jnp.float32).reshape(N_KV_HEADS, GROUP, 1, 1)
    m = jnp.maximum(jnp.max(s, axis=-1, keepdims=True), sink)
    e = jnp.exp(s - m)
    p = e / (jnp.sum(e, axis=-1, keepdims=True) + jnp.exp(sink - m))
    o = jnp.einsum('nkgqj,njkd->nqkgd', p.astype(vv.dtype), vv)
    return o.reshape(n, nq, TOKEN_WIDTH)


def conv_mixer(h, conv_prev, mk, mv, w_in, w_conv, w_out):
    t = h.shape[1]
    z = h @ w_in
    b = z[..., :TOKEN_WIDTH]
    c = z[..., TOKEN_WIDTH:2 * TOKEN_WIDTH]
    u = z[..., 2 * TOKEN_WIDTH:3 * TOKEN_WIDTH]
    qm = z[..., 3 * TOKEN_WIDTH:]
    ext = jnp.concatenate([conv_prev, c * u], axis=1)
    conv = sum(w_conv[k] * ext[:, k:k + t] for k in range(CONV_WIDTH))
    tok = b * conv
    out = jnp.concatenate([tok, cross_attention(qm, mk, mv)], axis=-1) @ w_out
    return out, ext[:, -(CONV_WIDTH - 1):]


def attn_project(h, w_in):
    n, t = h.shape[:2]
    z = h @ w_in
    q = z[..., :TOKEN_WIDTH].reshape(n, t, N_HEADS, HEAD_DIM)
    k = z[..., TOKEN_WIDTH:TOKEN_WIDTH + KV_WIDTH].reshape(n, t, N_KV_HEADS, HEAD_DIM)
    v = z[..., TOKEN_WIDTH + KV_WIDTH:TOKEN_WIDTH + 2 * KV_WIDTH].reshape(n, t, N_KV_HEADS, HEAD_DIM)
    qm = z[..., TOKEN_WIDTH + 2 * KV_WIDTH:]
    return q, k, v, qm


def swa_prompt(q, k, v, sinks):
    b, s = q.shape[:2]
    nb = s // WINDOW
    kb = k.reshape(b, nb, WINDOW, N_KV_HEADS, HEAD_DIM)
    vb = v.reshape(b, nb, WINDOW, N_KV_HEADS, HEAD_DIM)
    kk = jnp.concatenate([jnp.concatenate([jnp.zeros_like(kb[:, :1]), kb[:, :-1]], axis=1), kb], axis=2)
    vv = jnp.concatenate([jnp.concatenate([jnp.zeros_like(vb[:, :1]), vb[:, :-1]], axis=1), vb], axis=2)
    valid = (jnp.arange(nb)[:, None] > 0) | (jnp.arange(2 * WINDOW)[None, :] >= WINDOW)
    valid = jnp.broadcast_to(valid, (b, nb, 2 * WINDOW)).reshape(b * nb, 2 * WINDOW)
    o = band_attention(q.reshape(b * nb, WINDOW, N_HEADS, HEAD_DIM),
                       kk.reshape(b * nb, 2 * WINDOW, N_KV_HEADS, HEAD_DIM),
                       vv.reshape(b * nb, 2 * WINDOW, N_KV_HEADS, HEAD_DIM), sinks, valid)
    return o.reshape(b, s, TOKEN_WIDTH)


def setup_inputs(seed: int = 0) -> dict:
    key = jax.random.key(seed)
    ks = jax.random.split(key, 24)
    f32 = jnp.float32
    nrm = lambda k, shape, scale: jax.random.normal(k, shape, f32) * scale
    gain = lambda k, shape: 1.0 + 0.01 * jax.random.normal(k, shape, f32)
    d = D_MODEL
    return {
        "x_prompt": nrm(ks[0], (BATCH, SEQ, d), 1.0),
        "x_sample": nrm(ks[1], (DEC_BATCH, DEC_SEQ, d), 1.0),
        "mem_prompt": nrm(ks[2], (BATCH, N_MEM, d), 1.0),
        "state_conv": nrm(ks[3], (N_CONV_LAYERS, DEC_BATCH, CONV_WIDTH - 1, TOKEN_WIDTH), 1.0),
        "cache_win_k": nrm(ks[4], (N_ATTN_LAYERS, DEC_BATCH, WINDOW, N_KV_HEADS, HEAD_DIM), 1.0),
        "cache_win_v": nrm(ks[5], (N_ATTN_LAYERS, DEC_BATCH, WINDOW, N_KV_HEADS, HEAD_DIM), 1.0),
        "cache_mem_k": nrm(ks[6], (DEPTH, DEC_BATCH, N_MEM, MEM_HEADS, MEM_HEAD_DIM), 1.0),
        "cache_mem_v": nrm(ks[7], (DEPTH, DEC_BATCH, N_MEM, MEM_HEADS, MEM_HEAD_DIM), 1.0),
        "norm_mix": gain(ks[8], (DEPTH, d)),
        "norm_mem": gain(ks[9], (DEPTH, d)),
        "w_mem_kv": nrm(ks[10], (DEPTH, d, 2 * MEM_WIDTH), d ** -0.5),
        "norm_ffn": gain(ks[11], (DEPTH, d)),
        "w_gate": nrm(ks[12], (DEPTH, d, D_FF), d ** -0.5),
        "w_up": nrm(ks[13], (DEPTH, d, D_FF), d ** -0.5),
        "w_down": nrm(ks[14], (DEPTH, D_FF, d), D_FF ** -0.5),
        "conv_w_in": nrm(ks[15], (N_CONV_LAYERS, d, 3 * TOKEN_WIDTH + MEM_WIDTH), d ** -0.5),
        "conv_w": nrm(ks[16], (N_CONV_LAYERS, CONV_WIDTH, TOKEN_WIDTH), CONV_WIDTH ** -0.5),
        "conv_w_out": nrm(ks[17], (N_CONV_LAYERS, TOKEN_WIDTH + MEM_WIDTH, d), (TOKEN_WIDTH + MEM_WIDTH) ** -0.5),
        "attn_w_in": nrm(ks[18], (N_ATTN_LAYERS, d, TOKEN_WIDTH + 2 * KV_WIDTH + MEM_WIDTH), d ** -0.5),
        "attn_sinks": nrm(ks[19], (N_ATTN_LAYERS, N_HEADS), 0.5),
        "attn_w_out": nrm(ks[20], (N_ATTN_LAYERS, TOKEN_WIDTH + MEM_WIDTH, d), (TOKEN_WIDTH + MEM_WIDTH) ** -0.5),
        "norm_final": gain(ks[21], (d,)),
    }


def reference(x_prompt, x_sample, mem_prompt, state_conv, cache_win_k, cache_win_v, cache_mem_k, cache_mem_v,
              norm_mix, norm_mem, w_mem_kv, norm_ffn, w_gate, w_up, w_down,
              conv_w_in, conv_w, conv_w_out, attn_w_in, attn_sinks, attn_w_out, norm_final):
    xp, xs = x_prompt, x_sample
    bp, dbs = xp.shape[0], xs.shape[0]
    conv_p, conv_s, wk_p, wv_p, wk_s, wv_s, mk_p, mv_p = [], [], [], [], [], [], [], []
    for i in range(DEPTH):
        mkv = rmsnorm(mem_prompt, norm_mem[i]) @ w_mem_kv[i]
        mk = mkv[..., :MEM_WIDTH].reshape(bp, N_MEM, MEM_HEADS, MEM_HEAD_DIM)
        mv = mkv[..., MEM_WIDTH:].reshape(bp, N_MEM, MEM_HEADS, MEM_HEAD_DIM)
        mk_p.append(mk)
        mv_p.append(mv)
        hp = rmsnorm(xp, norm_mix[i])
        hs = rmsnorm(xs, norm_mix[i])
        j = i // 2
        if i % 2 == 0:
            zero_prev = jnp.zeros((bp, CONV_WIDTH - 1, TOKEN_WIDTH), hp.dtype)
            op, st_p = conv_mixer(hp, zero_prev, mk, mv, conv_w_in[j], conv_w[j], conv_w_out[j])
            os_, st_s = conv_mixer(hs, state_conv[j], cache_mem_k[i], cache_mem_v[i],
                                   conv_w_in[j], conv_w[j], conv_w_out[j])
            conv_p.append(st_p)
            conv_s.append(st_s)
        else:
            q, k, v, qm = attn_project(hp, attn_w_in[j])
            a = swa_prompt(q, k, v, attn_sinks[j])
            op = jnp.concatenate([a, cross_attention(qm, mk, mv)], axis=-1) @ attn_w_out[j]
            wk_p.append(k[:, -WINDOW:])
            wv_p.append(v[:, -WINDOW:])
            q, k, v, qm = attn_project(hs, attn_w_in[j])
            kk = jnp.concatenate([cache_win_k[j], k], axis=1)
            vv = jnp.concatenate([cache_win_v[j], v], axis=1)
            valid = jnp.ones((dbs, kk.shape[1]), dtype=bool)
            a = band_attention(q, kk, vv, attn_sinks[j], valid)
            os_ = jnp.concatenate([a, cross_attention(qm, cache_mem_k[i], cache_mem_v[i])], axis=-1) @ attn_w_out[j]
            wk_s.append(kk[:, -WINDOW:])
            wv_s.append(vv[:, -WINDOW:])
        xp = xp + op
        xs = xs + os_
        xp = xp + swiglu(rmsnorm(xp, norm_ffn[i]), w_gate[i], w_up[i], w_down[i])
        xs = xs + swiglu(rmsnorm(xs, norm_ffn[i]), w_gate[i], w_up[i], w_down[i])
    y_prompt = rmsnorm(xp, norm_final)
    y_sample = rmsnorm(xs, norm_final)
    new_conv_prompt = jnp.stack(conv_p)
    new_conv_sample = jnp.stack(conv_s)
    new_win_k_prompt = jnp.stack(wk_p)
    new_win_v_prompt = jnp.stack(wv_p)
    new_win_k_sample = jnp.stack(wk_s)
    new_win_v_sample = jnp.stack(wv_s)
    new_mem_k_prompt = jnp.stack(mk_p)
    new_mem_v_prompt = jnp.stack(mv_p)
    return (y_prompt, y_sample, new_conv_prompt, new_conv_sample, new_win_k_prompt, new_win_v_prompt,
            new_win_k_sample, new_win_v_sample, new_mem_k_prompt, new_mem_v_prompt)
```

```cpp
#include <hip/hip_runtime.h>
#include <hip/hip_cooperative_groups.h>
#include <cstdio>
#include <cstdint>
namespace cg = cooperative_groups;
namespace pg8 {
#define PG8_LAS __attribute__((address_space(3)))
typedef unsigned short bf16_t;
typedef short bf16x8 __attribute__((ext_vector_type(8)));
typedef float f32x4 __attribute__((ext_vector_type(4)));
typedef unsigned u32x4 __attribute__((ext_vector_type(4)));
typedef unsigned u32x2 __attribute__((ext_vector_type(2)));
constexpr int BM = 256, BK = 64, HALF = 128, HTB = HALF * BK * 2  , STAGE_BYTES = 8 * HTB, NXCD = 8, WGM = 8;

__host__ __device__ __forceinline__ int lds_byte(int r, int c) { const int st = (r >> 4) * 2 + (c >> 5), rr = r & 15, cc = c & 31, ob = rr * 64 + cc * 2; return st * 1024 + (ob ^ (((ob >> 9) & 1) << 5)); }
__host__ __device__ __forceinline__ void stage_rc(int b, int& R, int& C) { const int st = b / 1024, sb = b % 1024, swz = sb ^ (((sb >> 9) & 1) << 5); R = (st >> 1) * 16 + swz / 64; C = (st & 1) * 32 + (swz % 64) / 2; }
__host__ __device__ __forceinline__ int perm32(int rho) { const int n = rho >> 4, i = rho & 15; return 8 * (i >> 2) + 4 * n + (i & 3); }

struct Unit { int pm, pn, k0, nt; };
struct Gemm { const bf16_t* A; const bf16_t* Bt; int M, N, K; };

struct StaticOrder {
    int nM, nN, nwg, G, c, ntf;
    __host__ __device__ void init(int M, int N, int G_, int c_, int K) { nM = M / BM; nN = N / BM; nwg = nM * nN; G = G_; c = c_; ntf = K / BK; }
    __host__ __device__ bool next(int i, Unit& u) const {
        const long L = (long)i * G + c; if (L >= nwg) return false;
        int wgid = (int)L; { const int q = nwg / NXCD, r = nwg % NXCD, xcd = wgid % NXCD, off = wgid / NXCD; wgid = (xcd < r ? xcd * (q + 1) : r * (q + 1) + (xcd - r) * q) + off; }
        const int nig = WGM * nN, gid = wgid / nig, fm = gid * WGM, gsz = (nM - fm) < WGM ? (nM - fm) : WGM;
        u.pm = fm + ((wgid % nig) % gsz); u.pn = (wgid % nig) / gsz; u.k0 = 0; u.nt = ntf; return true;
    }
    __device__ __forceinline__ void a_ready(const Unit&) const {}
    __device__ __forceinline__ void done(const Unit&) const {}
};

__device__ __forceinline__ unsigned cvt_pk_bf16(float lo, float hi) { unsigned r; asm volatile("v_cvt_pk_bf16_f32 %0, %1, %2" : "=v"(r) : "v"(lo), "v"(hi)); return r; }

struct MemOrder {
    int G, c;
    __device__ bool next(int i, Unit& u) const { const int L = i * G + c; if (L >= 32) return false; const int li = L >> 4, r = L & 15; u.pm = li * 4 + (r >> 2); u.pn = li * 4 + (r & 3); u.k0 = 0; u.nt = 32; return true; }
    __device__ __forceinline__ void a_ready(const Unit&) const {}
    __device__ __forceinline__ void done(const Unit&) const {}
};

struct TailOrder {
    StaticOrder main; int G, c, snt, nsub;
    __device__ void init(int G_, int c_, int K, int snt_) { main.init(8192, 2048, G_, c_, K); G = G_; c = c_; snt = snt_; nsub = 8 * ((K / BK) / snt_); }
    __device__ bool next(int i, Unit& u) const {
        const int nm = c < 256 ? (256 - c + G - 1) / G : 0;
        if (i < nm) return main.next(i, u);
        const int Ls = (i - nm) * G + c; if (Ls >= nsub) return false;
        u.pm = 32; u.pn = Ls & 7; u.k0 = (Ls >> 3) * snt; u.nt = snt; return true;
    }
    __device__ __forceinline__ void a_ready(const Unit&) const {}
    __device__ __forceinline__ void done(const Unit&) const {}
};

struct EpiZ {
    static constexpr bool PERM = true, AFTER_DRAIN = false;
    __device__ __forceinline__ void init(f32x4 (&)[2][2][4][2], const Unit&, int, int, int, int) const {}
    bf16_t* O; int ldc; const float* RS;
    __device__ __forceinline__ void operator()(const f32x4 (&acc)[2][2][4][2], const Unit& u, int wr, int wc, int fr, int fq) const {
        const int row0 = u.pm * BM + wr * 64 + fr, col0 = u.pn * BM + wc * 32 + 8 * fq;
        float scv[2][4];
#pragma unroll
        for (int ai = 0; ai < 2; ++ai)
#pragma unroll
            for (int m = 0; m < 4; ++m) scv[ai][m] = RS ? RS[row0 + ai * HALF + m * 16] : 0.f;
#pragma unroll
        for (int ai = 0; ai < 2; ++ai)
#pragma unroll
            for (int m = 0; m < 4; ++m) scv[ai][m] = RS ? __builtin_amdgcn_rsqf(scv[ai][m] * (1.0f / 2048.0f) + 1e-6f) : 1.0f;
        asm volatile("" ::: "memory");
#pragma unroll
        for (int ai = 0; ai < 2; ++ai)
#pragma unroll
            for (int m = 0; m < 4; ++m) { bf16_t* rowp = O + (size_t)(row0 + ai * HALF + m * 16) * ldc + col0;
                const float sc = scv[ai][m];
#pragma unroll
                for (int bj = 0; bj < 2; ++bj) { const f32x4 v0 = acc[ai][bj][m][0] * sc, v1 = acc[ai][bj][m][1] * sc;
                    u32x4 w; w.x = cvt_pk_bf16(v0[0], v0[1]); w.y = cvt_pk_bf16(v0[2], v0[3]); w.z = cvt_pk_bf16(v1[0], v1[1]); w.w = cvt_pk_bf16(v1[2], v1[3]);
                    *(u32x4*)(rowp + bj * HALF) = w; } }
    }
};
struct EpiMem {
    static constexpr bool PERM = true, AFTER_DRAIN = false;
    __device__ __forceinline__ void init(f32x4 (&)[2][2][4][2], const Unit&, int, int, int, int) const {}
    float* outK; float* outV; bf16_t* MKV;
    __device__ __forceinline__ void operator()(const f32x4 (&acc)[2][2][4][2], const Unit& u, int wr, int wc, int fr, int fq) const {
        const int li = u.pm >> 2, row0 = (u.pm & 3) * BM + wr * 64 + fr, ct = (u.pn & 3) * BM, isv = ct >= 512;
        const int col0 = ct + wc * 32 + 8 * fq;
        float* ob = (isv ? outV : outK) + (size_t)li * (1024 * 512) + (col0 - (isv ? 512 : 0));
        bf16_t* bb = MKV + (size_t)li * (1024 * 1024) + col0;
#pragma unroll
        for (int ai = 0; ai < 2; ++ai)
#pragma unroll
            for (int m = 0; m < 4; ++m) { const int row = row0 + ai * HALF + m * 16;
#pragma unroll
                for (int bj = 0; bj < 2; ++bj) { const f32x4 v0 = acc[ai][bj][m][0], v1 = acc[ai][bj][m][1];
                    *(f32x4*)(ob + (size_t)row * 512 + bj * HALF) = v0; *(f32x4*)(ob + (size_t)row * 512 + bj * HALF + 4) = v1;
                    u32x4 w; w.x = cvt_pk_bf16(v0[0], v0[1]); w.y = cvt_pk_bf16(v0[2], v0[3]); w.z = cvt_pk_bf16(v1[0], v1[1]); w.w = cvt_pk_bf16(v1[2], v1[3]);
                    *(u32x4*)(bb + (size_t)row * 1024 + bj * HALF) = w; } }
    }
};
struct EpiResid {
    static constexpr bool PERM = true, AFTER_DRAIN = false;
    __device__ __forceinline__ void init(f32x4 (&acc)[2][2][4][2], const Unit& u, int wr, int wc, int fr, int fq) const {
        if (u.pm == 32) return;
        const int row0 = u.pm * BM + wr * 64 + fr, col0 = u.pn * BM + wc * 32 + 8 * fq;
#pragma unroll
        for (int ai = 0; ai < 2; ++ai)
#pragma unroll
            for (int m = 0; m < 4; ++m) { const size_t off = (size_t)(row0 + ai * HALF + m * 16) * 2048 + col0;
#pragma unroll
                for (int bj = 0; bj < 2; ++bj) {
                    if (baseP) { acc[ai][bj][m][0] = *(const f32x4*)(baseP + off + bj * HALF); acc[ai][bj][m][1] = *(const f32x4*)(baseP + off + bj * HALF + 4); }
                    else { const u32x4 w = *(const u32x4*)(XB + off + bj * HALF);
                        acc[ai][bj][m][0] = (f32x4){__builtin_bit_cast(float, w.x << 16), __builtin_bit_cast(float, w.x & 0xffff0000u), __builtin_bit_cast(float, w.y << 16), __builtin_bit_cast(float, w.y & 0xffff0000u)};
                        acc[ai][bj][m][1] = (f32x4){__builtin_bit_cast(float, w.z << 16), __builtin_bit_cast(float, w.z & 0xffff0000u), __builtin_bit_cast(float, w.w << 16), __builtin_bit_cast(float, w.w & 0xffff0000u)}; } } }
#pragma unroll
        for (int ai = 0; ai < 2; ++ai)
#pragma unroll
            for (int m = 0; m < 4; ++m)
                asm volatile("" : "+v"(acc[ai][0][m][0]), "+v"(acc[ai][0][m][1]), "+v"(acc[ai][1][m][0]), "+v"(acc[ai][1][m][1]));
    }
    const float* baseP; float* X; float* P; bf16_t* XB; float* RS; bool wb;
    __device__ __forceinline__ void operator()(const f32x4 (&acc)[2][2][4][2], const Unit& u, int wr, int wc, int fr, int fq) const {
        const int row0 = u.pm * BM + wr * 64 + fr, col0 = u.pn * BM + wc * 32 + 8 * fq;
        if (u.pm == 32) {
            float* pb = P + (size_t)(u.k0 / u.nt) * (256 * 2048) - (size_t)8192 * 2048;
#pragma unroll
            for (int ai = 0; ai < 2; ++ai)
#pragma unroll
                for (int m = 0; m < 4; ++m) { const size_t off = (size_t)(row0 + ai * HALF + m * 16) * 2048 + col0;
#pragma unroll
                    for (int bj = 0; bj < 2; ++bj) { *(f32x4*)(pb + off + bj * HALF) = acc[ai][bj][m][0]; *(f32x4*)(pb + off + bj * HALF + 4) = acc[ai][bj][m][1]; } }
            return;
        }
#pragma unroll
        for (int ai = 0; ai < 2; ++ai)
#pragma unroll
            for (int m = 0; m < 4; ++m) { const size_t off = (size_t)(row0 + ai * HALF + m * 16) * 2048 + col0; float ss = 0.f;
#pragma unroll
                for (int bj = 0; bj < 2; ++bj) { const f32x4 x0 = acc[ai][bj][m][0], x1 = acc[ai][bj][m][1];
                    if (X) { *(f32x4*)(X + off + bj * HALF) = x0; *(f32x4*)(X + off + bj * HALF + 4) = x1; }
                    ss += ((x0[0] * x0[0] + x0[1] * x0[1]) + (x0[2] * x0[2] + x0[3] * x0[3])) + ((x1[0] * x1[0] + x1[1] * x1[1]) + (x1[2] * x1[2] + x1[3] * x1[3]));
                    if (wb) { u32x4 w; w.x = cvt_pk_bf16(x0[0], x0[1]); w.y = cvt_pk_bf16(x0[2], x0[3]); w.z = cvt_pk_bf16(x1[0], x1[1]); w.w = cvt_pk_bf16(x1[2], x1[3]); *(u32x4*)(XB + off + bj * HALF) = w; } }
                ss += __shfl_xor(ss, 16); ss += __shfl_xor(ss, 32);
                if (fq == 0) RS[(size_t)(u.pn * 4 + wc) * 8448 + row0 + ai * HALF + m * 16] = ss;
                asm volatile("" ::: "memory"); }
    }
};
struct EpiSwiglu {
    static constexpr bool PERM = true, AFTER_DRAIN = false;
    __device__ __forceinline__ void init(f32x4 (&)[2][2][4][2], const Unit&, int, int, int, int) const {}
    bf16_t* O; const float* RS;
    __device__ __forceinline__ void operator()(const f32x4 (&acc)[2][2][4][2], const Unit& u, int wr, int wc, int fr, int fq) const {
        const int row0 = u.pm * BM + wr * 64 + fr, col0 = u.pn * HALF + wc * 32 + 8 * fq;
        float scv[2][4];
#pragma unroll
        for (int ai = 0; ai < 2; ++ai)
#pragma unroll
            for (int m = 0; m < 4; ++m) scv[ai][m] = RS[row0 + ai * HALF + m * 16];
#pragma unroll
        for (int ai = 0; ai < 2; ++ai)
#pragma unroll
            for (int m = 0; m < 4; ++m) scv[ai][m] = __builtin_amdgcn_rsqf(scv[ai][m] * (1.0f / 2048.0f) + 1e-6f);
        asm volatile("" ::: "memory");
#pragma unroll
        for (int ai = 0; ai < 2; ++ai)
#pragma unroll
            for (int m = 0; m < 4; ++m) { bf16_t* rowp = O + (size_t)(row0 + ai * HALF + m * 16) * 5632 + col0;
                float r[8]; const float sc = scv[ai][m];
#pragma unroll
                for (int n = 0; n < 2; ++n)
#pragma unroll
                    for (int j = 0; j < 4; ++j) { const float g = acc[ai][0][m][n][j] * sc, up = acc[ai][1][m][n][j] * sc;
                        const float e = __builtin_amdgcn_exp2f(g * -1.4426950408889634f); r[n * 4 + j] = g * __builtin_amdgcn_rcpf(1.0f + e) * up; }
                u32x4 w; w.x = cvt_pk_bf16(r[0], r[1]); w.y = cvt_pk_bf16(r[2], r[3]); w.z = cvt_pk_bf16(r[4], r[5]); w.w = cvt_pk_bf16(r[6], r[7]);
                *(u32x4*)rowp = w; }
    }
};

template <class Epi, class Sched, bool ALIGN_EPI = false, bool SP2 = false>
__device__ __forceinline__ void gemm_phase(PG8_LAS unsigned char* lds, const Gemm g, const Sched& S, const Epi& E) {
    int tid_ = threadIdx.x; asm volatile("" : "+v"(tid_));
    const int tid = tid_, wid = __builtin_amdgcn_readfirstlane(tid >> 6), lane = tid & 63, wr = wid >> 2, wc = wid & 3, fr = lane & 15, fq = lane >> 4;
    const int K = g.K;
    unsigned voffA[2], voffB[2];
#pragma unroll
    for (int i = 0; i < 2; ++i) { int R, C; stage_rc(tid * 16 + i * 8192, R, C); const int Rb = Epi::PERM ? ((R & ~31) + perm32(R & 31)) : R;
        voffA[i] = (unsigned)(R * K + C) * 2u; voffB[i] = (unsigned)(Rb * K + C) * 2u; }
    const size_t kstep = (size_t)(BK * 2);
    const size_t hstep = (size_t)HALF * K * 2;
    const size_t tstep = 2 * hstep;
    const unsigned ldsw = (unsigned)wid * 1024u;
    const int aoff = lds_byte(wr * 64 + fr, fq * 8), boff = lds_byte(wc * 32 + fr, fq * 8);
#define PG8_SA(b, h) (((b) * 2 + (h)) * HTB)
#define PG8_SB(b, h) ((4 + (b) * 2 + (h)) * HTB)
#define PG8_STAGE(bufoff, gbase, voff) do { _Pragma("unroll") for (int _i = 0; _i < 2; ++_i) \
        __builtin_amdgcn_global_load_lds((const unsigned*)((const char*)(gbase) + (voff)[_i]), (PG8_LAS unsigned*)(lds + (bufoff) + ldsw + _i * 8192), 16, 0, 0); } while (0)
#define PG8_LDA(dst, b, h) do { _Pragma("unroll") for (int m = 0; m < 4; ++m) _Pragma("unroll") for (int k = 0; k < 2; ++k) dst[m][k] = *(const PG8_LAS bf16x8*)(lds + PG8_SA(b, h) + aoff + m * 2048 + k * 1024); } while (0)
#define PG8_LDB(dst, b, h) do { _Pragma("unroll") for (int n = 0; n < 2; ++n) _Pragma("unroll") for (int k = 0; k < 2; ++k) dst[n][k] = *(const PG8_LAS bf16x8*)(lds + PG8_SB(b, h) + boff + n * 2048 + k * 1024); } while (0)
#define PG8_MMA(ai, bj, At, Bt) do { __builtin_amdgcn_s_setprio(1); _Pragma("unroll") for (int m = 0; m < 4; ++m) _Pragma("unroll") for (int n = 0; n < 2; ++n) _Pragma("unroll") for (int k = 0; k < 2; ++k) \
        acc[ai][bj][m][n] = __builtin_amdgcn_mfma_f32_16x16x32_bf16(Bt[n][k], At[m][k], acc[ai][bj][m][n], 0, 0, 0); __builtin_amdgcn_s_setprio(0); } while (0)
#define PG8_WAIT_V(n) asm volatile("s_waitcnt vmcnt(" #n ")" ::: "memory")
#define PG8_WAIT_L(n) asm volatile("s_waitcnt lgkmcnt(" #n ")" ::: "memory")
#define PG8_BAR __builtin_amdgcn_s_barrier()
#define PG8_SCHED __builtin_amdgcn_sched_barrier(0)
    Unit cur, nxt; int ui = 0;
    if (!S.next(0, cur)) return;
    f32x4 acc[2][2][4][2];
#pragma unroll
    for (int a = 0; a < 2; ++a)
#pragma unroll
        for (int b = 0; b < 2; ++b)
#pragma unroll
            for (int m = 0; m < 4; ++m)
#pragma unroll
                for (int n = 0; n < 2; ++n) acc[a][b][m][n] = (f32x4){0.f, 0.f, 0.f, 0.f};
    E.init(acc, cur, wr, wc, fr, fq);
    bf16x8 At[4][2], B0[2][2], B1[2][2];
    const char* cA = (const char*)g.A + (size_t)cur.pm * tstep + (size_t)cur.k0 * kstep; const char* cB = (const char*)g.Bt + (size_t)cur.pn * tstep + (size_t)cur.k0 * kstep;
    S.a_ready(cur);
    if constexpr (SP2) {
        PG8_STAGE(PG8_SB(0, 0), cB, voffB); PG8_STAGE(PG8_SB(0, 1), cB + hstep, voffB); PG8_STAGE(PG8_SA(0, 0), cA, voffA); PG8_STAGE(PG8_SA(0, 1), cA + hstep, voffA);
        if (wr == 1) PG8_BAR;
        PG8_WAIT_V(2); PG8_BAR;
        PG8_STAGE(PG8_SB(1, 0), cB + kstep, voffB); PG8_STAGE(PG8_SA(1, 0), cA + kstep, voffA); PG8_STAGE(PG8_SB(1, 1), cB + hstep + kstep, voffB);
        PG8_WAIT_V(6); PG8_BAR;
    } else {
        PG8_STAGE(PG8_SB(0, 0), cB, voffB); PG8_STAGE(PG8_SA(0, 0), cA, voffA); PG8_STAGE(PG8_SB(0, 1), cB + hstep, voffB); PG8_STAGE(PG8_SA(0, 1), cA + hstep, voffA);
        if (wr == 1) PG8_BAR;
        PG8_WAIT_V(4); PG8_BAR;
        PG8_STAGE(PG8_SB(1, 0), cB + kstep, voffB); PG8_STAGE(PG8_SA(1, 0), cA + kstep, voffA); PG8_STAGE(PG8_SB(1, 1), cB + hstep + kstep, voffB);
        PG8_WAIT_V(6); PG8_BAR;
    }
    for (;;) {
        const bool has_next = S.next(ui + 1, nxt);
        const char* nA = has_next ? (const char*)g.A + (size_t)nxt.pm * tstep + (size_t)nxt.k0 * kstep : cA; const char* nB = has_next ? (const char*)g.Bt + (size_t)nxt.pn * tstep + (size_t)nxt.k0 * kstep : cB;
        const int nt = cur.nt;
        for (int t = 0; t < nt; t += 2) {
            const bool last = (t == nt - 2);
            const char* a1 = cA + (size_t)(t + 1) * kstep;
            const char* a2 = last ? nA : cA + (size_t)(t + 2) * kstep; const char* b2 = last ? nB : cB + (size_t)(t + 2) * kstep;
            const char* a3 = a2 + kstep; const char* b3 = b2 + kstep;
            if (last && has_next) S.a_ready(nxt);
            if constexpr (SP2) {
            PG8_LDB(B0, 0, 0); PG8_LDB(B1, 0, 1); PG8_SCHED; PG8_LDA(At, 0, 0); PG8_STAGE(PG8_SA(1, 1), a1 + hstep, voffA);
            PG8_WAIT_V(8); PG8_WAIT_L(0); PG8_BAR; PG8_MMA(0, 0, At, B0); PG8_MMA(0, 1, At, B1); PG8_BAR; PG8_SCHED;
            PG8_LDA(At, 0, 1); PG8_STAGE(PG8_SB(0, 0), b2, voffB); PG8_STAGE(PG8_SB(0, 1), b2 + hstep, voffB); PG8_STAGE(PG8_SA(0, 0), a2, voffA);
            PG8_WAIT_V(8); PG8_WAIT_L(0); PG8_BAR; PG8_MMA(1, 0, At, B0); PG8_MMA(1, 1, At, B1); PG8_BAR; PG8_SCHED;
            PG8_LDB(B0, 1, 0); PG8_LDB(B1, 1, 1); PG8_SCHED; PG8_LDA(At, 1, 0); PG8_STAGE(PG8_SA(0, 1), a2 + hstep, voffA);
            PG8_WAIT_V(8); PG8_WAIT_L(0); PG8_BAR; PG8_MMA(0, 0, At, B0); PG8_MMA(0, 1, At, B1); PG8_BAR; PG8_SCHED;
            PG8_LDA(At, 1, 1); PG8_STAGE(PG8_SB(1, 0), b3, voffB); PG8_STAGE(PG8_SB(1, 1), b3 + hstep, voffB); PG8_STAGE(PG8_SA(1, 0), a3, voffA);
            PG8_WAIT_V(8); PG8_WAIT_L(0); PG8_BAR; PG8_MMA(1, 0, At, B0); PG8_MMA(1, 1, At, B1); PG8_BAR; PG8_SCHED;
            } else {
            PG8_LDB(B0, 0, 0); PG8_SCHED; PG8_LDA(At, 0, 0); PG8_STAGE(PG8_SA(1, 1), a1 + hstep, voffA);
            PG8_WAIT_L(8); PG8_BAR; PG8_WAIT_L(0); PG8_MMA(0, 0, At, B0); PG8_BAR; PG8_SCHED;
            PG8_LDB(B1, 0, 1); PG8_STAGE(PG8_SB(0, 0), b2, voffB);
            PG8_BAR; PG8_WAIT_L(0); PG8_MMA(0, 1, At, B1); PG8_BAR;
            PG8_LDA(At, 0, 1); PG8_STAGE(PG8_SA(0, 0), a2, voffA);
            PG8_BAR; PG8_WAIT_L(0); PG8_MMA(1, 0, At, B0); PG8_BAR; PG8_SCHED;
            PG8_STAGE(PG8_SB(0, 1), b2 + hstep, voffB);
            PG8_WAIT_V(6); PG8_BAR; PG8_MMA(1, 1, At, B1); PG8_BAR;
            PG8_LDB(B0, 1, 0); PG8_SCHED; PG8_LDA(At, 1, 0); PG8_STAGE(PG8_SA(0, 1), a2 + hstep, voffA);
            PG8_WAIT_L(8); PG8_BAR; PG8_WAIT_L(0); PG8_MMA(0, 0, At, B0); PG8_BAR; PG8_SCHED;
            PG8_LDB(B1, 1, 1); PG8_STAGE(PG8_SB(1, 0), b3, voffB);
            PG8_BAR; PG8_WAIT_L(0); PG8_MMA(0, 1, At, B1); PG8_BAR;
            PG8_LDA(At, 1, 1); PG8_STAGE(PG8_SA(1, 0), a3, voffA);
            PG8_BAR; PG8_WAIT_L(0); PG8_MMA(1, 0, At, B0); PG8_BAR; PG8_SCHED;
            PG8_STAGE(PG8_SB(1, 1), b3 + hstep, voffB);
            PG8_WAIT_V(6); PG8_BAR; PG8_MMA(1, 1, At, B1); PG8_BAR;
            }
        }
        if constexpr (ALIGN_EPI) { if (wr == 0) PG8_BAR; }
        if constexpr (!Epi::AFTER_DRAIN) { E(acc, cur, wr, wc, fr, fq); S.done(cur); }
        if (!has_next) break;
#pragma unroll
        for (int a = 0; a < 2; ++a)
#pragma unroll
            for (int b = 0; b < 2; ++b)
#pragma unroll
                for (int m = 0; m < 4; ++m)
#pragma unroll
                    for (int n = 0; n < 2; ++n) acc[a][b][m][n] = (f32x4){0.f, 0.f, 0.f, 0.f};
        E.init(acc, nxt, wr, wc, fr, fq);
        cur = nxt; cA = nA; cB = nB; ++ui;
        if constexpr (ALIGN_EPI) { if (wr == 1) PG8_BAR; }
    }
    PG8_WAIT_V(0);
    if constexpr (!ALIGN_EPI) { if (wr == 0) PG8_BAR; }
    PG8_BAR;
    if constexpr (Epi::AFTER_DRAIN) { E.fused(acc, cur, wr, wc, fr, fq, lds, wid, lane); S.done(cur); }
#undef PG8_SA
#undef PG8_SB
#undef PG8_STAGE
#undef PG8_LDA
#undef PG8_LDB
#undef PG8_MMA
#undef PG8_WAIT_V
#undef PG8_WAIT_L
#undef PG8_BAR
#undef PG8_SCHED
}
}

#define LAS __attribute__((address_space(3)))
typedef unsigned short bf16;
typedef short bf16x8 __attribute__((ext_vector_type(8)));
typedef float f32x4 __attribute__((ext_vector_type(4)));
typedef unsigned u32x4 __attribute__((ext_vector_type(4)));
typedef unsigned u32x2 __attribute__((ext_vector_type(2)));
constexpr int DM = 2048, NPR = 8192, NSR = 256, MT = NPR + NSR, FF = 5632, TW = 1536, NIN0 = 5120, NIN1 = 2560, NGU = 2 * FF;
constexpr int NTHREADS = 512, NWAVES = 8;
constexpr int LDS_BYTES = 147456, MISC_OFF = LDS_BYTES - 64;
constexpr size_t OUT_CP = (size_t)MT * DM, OUT_CS = OUT_CP + 12288, OUT_WKP = OUT_CS + 98304, OUT_WVP = OUT_WKP + 131072, OUT_WKS = OUT_WVP + 131072,
                 OUT_WVS = OUT_WKS + 1048576, OUT_MK = OUT_WVS + 1048576, OUT_MV = OUT_MK + 1048576, OUT_END = OUT_MV + 1048576;
constexpr size_t MiB = 1u << 20;
constexpr size_t WS_WIN0 = 0, WS_WMEM = 20 * MiB, WS_WIN1 = 28 * MiB, WS_WOUT = 38 * MiB, WS_WGU = 54 * MiB, WS_WDN = 142 * MiB, WS_H = 186 * MiB, WS_MEMH = 219 * MiB,
                 WS_MIX = 227 * MiB, WS_ZA = 260 * MiB, WS_MKV = 351 * MiB, WS_BAR = 355 * MiB, WS_RS = 379 * MiB, WS_RSP = 380 * MiB, WS_PART = 384 * MiB, WS_END = 430 * MiB;
static_assert((size_t)NIN0 * DM * 2 <= WS_WMEM - WS_WIN0 && (size_t)2 * 1024 * DM * 2 <= WS_WIN1 - WS_WMEM && (size_t)NIN1 * DM * 2 <= WS_WOUT - WS_WIN1 && (size_t)2 * DM * DM * 2 <= WS_WGU - WS_WOUT &&
              (size_t)2 * NGU * DM * 2 <= WS_WDN - WS_WGU && (size_t)2 * DM * FF * 2 <= WS_H - WS_WDN && (size_t)MT * DM * 2 <= WS_MEMH - WS_H && (size_t)2 * 1024 * DM * 2 <= WS_MIX - WS_MEMH &&
              (size_t)MT * DM * 2 <= WS_ZA - WS_MIX && (size_t)MT * FF * 2 <= WS_MKV - WS_ZA && (size_t)MT * NIN0 * 2 <= WS_MKV - WS_ZA && (size_t)2 * 1024 * 1024 * 2 <= WS_BAR - WS_MKV, "d_ws map");

struct Params { const float* in[22]; float* out; unsigned char* ws; };
enum { I_XP = 0, I_XS, I_MEMP, I_SCONV, I_CWK, I_CWV, I_CMK, I_CMV, I_NMIX, I_NMEM, I_WMEMKV, I_NFFN, I_WGATE, I_WUP, I_WDOWN, I_CWIN, I_CW, I_CWOUT, I_AWIN, I_SINKS, I_AWOUT, I_NFINAL };

__device__ __forceinline__ unsigned f2bf(float f) { unsigned u = __builtin_bit_cast(unsigned, f); return (u + 0x7fffu + ((u >> 16) & 1u)) >> 16; }
__device__ __forceinline__ unsigned pk2(float lo, float hi) { return f2bf(lo) | (f2bf(hi) << 16); }
__device__ __forceinline__ float bf_lo(unsigned w) { return __builtin_bit_cast(float, w << 16); }
__device__ __forceinline__ float bf_hi(unsigned w) { return __builtin_bit_cast(float, w & 0xffff0000u); }
__device__ __forceinline__ float wave_sum(float v) {
#pragma unroll
    for (int o = 1; o < 64; o <<= 1) v += __shfl_xor(v, o);
    return v;
}
#define LDS_WAIT() asm volatile("s_waitcnt lgkmcnt(0)" ::: "memory")
__device__ __forceinline__ int otid() { int t = threadIdx.x; asm volatile("" : "+v"(t)); return t; }

#define XB_TMO      128
#define XB_XCNT(j)  (256  + 64 * (j))
#define XB_XSUB(j)  (1280 + 64 * (j))
#define XB_XGEN(j)  (2304 + 64 * (j))
#define XB_TOP      3328
#define XB_TOPGEN   3392
#define XCD_BAR_WORDS 3456
#define XB_SPIN_CAP (1u << 18)

__device__ __forceinline__ unsigned xb_ld(unsigned* p)              { return __hip_atomic_load(p, __ATOMIC_RELAXED, __HIP_MEMORY_SCOPE_AGENT); }
__device__ __forceinline__ unsigned xb_add(unsigned* p, unsigned v) { return __hip_atomic_fetch_add(p, v, __ATOMIC_RELAXED, __HIP_MEMORY_SCOPE_AGENT); }
__device__ __forceinline__ unsigned xb_xcc_id() { return (unsigned)__builtin_amdgcn_s_getreg((3 << 11) | 20) & 0xFu; }
#define XB_SPIN(cond, bar) do { unsigned _sp = 0; while (cond) { __builtin_amdgcn_s_sleep(1); \
    if ((++_sp & 255u) == 0u) { if (xb_ld(&(bar)[XB_TMO])) break; if (_sp > XB_SPIN_CAP) { atomicAdd(&(bar)[XB_TMO], 1u); break; } } } } while (0)

struct XcdBarrier {
    unsigned* bar; unsigned x;
    volatile LAS unsigned* st;
};

__device__ __forceinline__ XcdBarrier xcd_barrier_post(unsigned* bar, volatile LAS unsigned* st) {
    XcdBarrier b; b.bar = bar; b.x = xb_xcc_id(); b.st = st;
    if (threadIdx.x == 0) (void)xb_add(&bar[XB_XCNT(b.x)], 1u);
    return b;
}
__device__ __forceinline__ void xcd_barrier_complete(unsigned* bar, unsigned x, unsigned& nloc, unsigned& nx) {
    const unsigned G = gridDim.x * gridDim.y * gridDim.z;
    unsigned sum, cnt, mine, sp = 0u;
    for (;;) {
        sum = 0u; cnt = 0u; mine = 0u;
#pragma unroll
        for (unsigned j = 0; j < 16; ++j) { const unsigned c = xb_ld(&bar[XB_XCNT(j)]); sum += c; cnt += (c > 0u) ? 1u : 0u; mine = (j == x) ? c : mine; }
        if (sum == G) break;
        __builtin_amdgcn_s_sleep(1);
        if ((++sp & 255u) == 0u) { if (xb_ld(&bar[XB_TMO])) break; if (sp > XB_SPIN_CAP) { atomicAdd(&bar[XB_TMO], 1u); break; } }
    }
    nloc = mine > 0u ? mine : 1u; nx = cnt > 0u ? cnt : 1u;
}

__device__ __forceinline__ void xcd_barrier(const XcdBarrier& b) {
    asm volatile("s_waitcnt vmcnt(0)" ::: "memory");
    __syncthreads();
    if (threadIdx.x == 0) {
        unsigned* bar = b.bar;
        __builtin_amdgcn_s_waitcnt(0);
        unsigned nloc = b.st[0], nx = b.st[1];
        if (nloc == 0u) { xcd_barrier_complete(bar, b.x, nloc, nx); b.st[0] = nloc; b.st[1] = nx; }
        const unsigned old = xb_add(&bar[XB_XSUB(b.x)], 1u);
        const unsigned gen = old / nloc;
        if (old + 1u == (gen + 1u) * nloc) {
            __builtin_amdgcn_fence(__ATOMIC_RELEASE, "agent");
            asm volatile("s_waitcnt vmcnt(0)" ::: "memory");
            const unsigned og = xb_add(&bar[XB_TOP], 1u);
            const unsigned tg = og / nx;
            if (og + 1u == (tg + 1u) * nx) xb_add(&bar[XB_TOPGEN], 1u);
            else XB_SPIN(xb_ld(&bar[XB_TOPGEN]) == tg, bar);
            __builtin_amdgcn_fence(__ATOMIC_ACQUIRE, "agent");
            xb_add(&bar[XB_XGEN(b.x)], 1u);
            asm volatile("s_waitcnt vmcnt(0)" ::: "memory");
        } else {
            XB_SPIN(xb_ld(&bar[XB_XGEN(b.x)]) == gen, bar);
            __builtin_amdgcn_fence(__ATOMIC_ACQUIRE, "agent");
            asm volatile("s_waitcnt vmcnt(0)" ::: "memory");
        }
    }
    __syncthreads();
}

struct TItem { const float* W; bf16* WT; const float* gk; int K, N, k0, n0, d0; };
__device__ __forceinline__ void titem_load(const TItem& t, float (&wv)[32], int lane) {
#pragma unroll
    for (int i = 0; i < 32; ++i) wv[i] = t.W[(size_t)(t.k0 + 2 * i + (lane >> 5)) * t.N + t.n0 + (lane & 31)];
}
__device__ __forceinline__ void titem_copy(float (&d)[32], const float (&s)[32]) {
#pragma unroll
    for (int i = 0; i < 32; ++i) d[i] = s[i];
}
__device__ __forceinline__ void titem_store(const TItem& t, const float (&wv)[32], LAS float* scr, int lane) {
    const int c = lane & 7;
    f32x4 ga = (f32x4){1.f, 1.f, 1.f, 1.f}, gb = ga;
    if (t.gk) { ga = *(const f32x4*)(t.gk + t.k0 + 8 * c); gb = *(const f32x4*)(t.gk + t.k0 + 8 * c + 4); }
#pragma unroll
    for (int i = 0; i < 32; ++i) scr[(2 * i + (lane >> 5)) * 33 + (lane & 31)] = wv[i];
    LDS_WAIT(); asm volatile("" ::: "memory");
#pragma unroll
    for (int j = 0; j < 4; ++j) { const int n = (lane >> 3) + 8 * j; const LAS float* s = scr + (8 * c) * 33 + n;
        u32x4 o; o.x = pk2(s[0 * 33] * ga.x, s[1 * 33] * ga.y); o.y = pk2(s[2 * 33] * ga.z, s[3 * 33] * ga.w); o.z = pk2(s[4 * 33] * gb.x, s[5 * 33] * gb.y); o.w = pk2(s[6 * 33] * gb.z, s[7 * 33] * gb.w);
        *(u32x4*)(t.WT + (size_t)(t.d0 + n) * t.K + t.k0 + 8 * c) = o; }
    LDS_WAIT(); asm volatile("" ::: "memory");
}
constexpr size_t PSTRIDE = (size_t)256 * 2048;
__device__ __forceinline__ float load_row_sumsq(f32x4 (&v)[8], const float* xrow, float* xw, const float* part, int npart, int lane) {
    const f32x4* xr = (const f32x4*)xrow + lane; float s = 0.f;
#pragma unroll
    for (int j = 0; j < 8; ++j) v[j] = xr[64 * j];
    if (npart > 0) {
        for (int q = 0; q < npart; ++q) { const f32x4* pr = (const f32x4*)(part + (size_t)q * PSTRIDE) + lane;
#pragma unroll
            for (int j = 0; j < 8; ++j) v[j] += pr[64 * j]; }
        f32x4* xo = (f32x4*)xw + lane;
#pragma unroll
        for (int j = 0; j < 8; ++j) xo[64 * j] = v[j];
    }
#pragma unroll
    for (int j = 0; j < 8; ++j) s += (v[j].x * v[j].x + v[j].y * v[j].y) + (v[j].z * v[j].z + v[j].w * v[j].w);
    return wave_sum(s);
}
__device__ __forceinline__ void rms_row_bf16(const float* xrow, float* xw, const float* part, int npart, const float* g, bf16* orow, int lane) {
    f32x4 v[8]; const float r = 1.0f / sqrtf(load_row_sumsq(v, xrow, xw, part, npart, lane) * (1.0f / DM) + 1e-6f);
    const f32x4* gr = (const f32x4*)g + lane; u32x2* o8 = (u32x2*)orow + lane;
#pragma unroll
    for (int j = 0; j < 8; ++j) { const f32x4 gg = gr[64 * j]; u32x2 w; w.x = pk2(v[j].x * r * gg.x, v[j].y * r * gg.y); w.y = pk2(v[j].z * r * gg.z, v[j].w * r * gg.w); o8[64 * j] = w; }
}
__device__ __forceinline__ void fixup_phase(float* X, const float* part, int npart, bf16* XB, float* RS, const float* RSP, LAS float* red, int bx, int G, int tid) {
    const int lane = tid & 63, wave = tid >> 6;
    for (int r = bx; r < NSR; r += G) {
        const size_t o = (size_t)(NPR + r) * DM + wave * 256 + lane * 4;
        f32x4 v = *(const f32x4*)(X + o);
        const float* pp = part + (size_t)r * DM + wave * 256 + lane * 4;
        f32x4 q[22];
#pragma unroll
        for (int i = 0; i < 22; ++i) q[i] = i < npart ? *(const f32x4*)(pp + (size_t)i * PSTRIDE) : (f32x4){0.f, 0.f, 0.f, 0.f};
#pragma unroll
        for (int i = 0; i < 22; ++i) v += q[i];
        *(f32x4*)(X + o) = v;
        u32x2 w; w.x = pk2(v.x, v.y); w.y = pk2(v.z, v.w); *(u32x2*)(XB + o) = w;
        const float ss = wave_sum((v.x * v.x + v.y * v.y) + (v.z * v.z + v.w * v.w));
        __syncthreads();
        if (lane == 0) red[wave] = ss;
        __syncthreads();
        if (tid == 0) RS[NPR + r] = ((red[0] + red[1]) + (red[2] + red[3])) + ((red[4] + red[5]) + (red[6] + red[7]));
    }
    for (int i = bx * NTHREADS + tid; i < NPR * 16; i += G * NTHREADS) {
        const int row = i >> 4, sub = i & 15;
        float s = RSP[(size_t)sub * MT + row] + RSP[(size_t)(sub + 16) * MT + row];
        s += __shfl_xor(s, 1); s += __shfl_xor(s, 2); s += __shfl_xor(s, 4); s += __shfl_xor(s, 8);
        if (sub == 0) RS[row] = s;
    }
}
__device__ __forceinline__ void final_sample_rows(float* X, const float* part, int npart, const float* g, LAS float* red, int bx, int G, int tid) {
    const int lane = tid & 63, wave = tid >> 6;
    for (int r = bx; r < NSR; r += G) {
        const size_t o = (size_t)(NPR + r) * DM + wave * 256 + lane * 4;
        f32x4 v = *(const f32x4*)(X + o);
        const float* pp = part + (size_t)r * DM + wave * 256 + lane * 4;
        f32x4 q[22];
#pragma unroll
        for (int i = 0; i < 22; ++i) q[i] = i < npart ? *(const f32x4*)(pp + (size_t)i * PSTRIDE) : (f32x4){0.f, 0.f, 0.f, 0.f};
        const f32x4 gg = *(const f32x4*)(g + wave * 256 + lane * 4);
#pragma unroll
        for (int i = 0; i < 22; ++i) v += q[i];
        const float ss = wave_sum((v.x * v.x + v.y * v.y) + (v.z * v.z + v.w * v.w));
        __syncthreads();
        if (lane == 0) red[wave] = ss;
        __syncthreads();
        const float tot = ((red[0] + red[1]) + (red[2] + red[3])) + ((red[4] + red[5]) + (red[6] + red[7]));
        const float rinv = 1.0f / sqrtf(tot * (1.0f / DM) + 1e-6f);
        *(f32x4*)(X + o) = v * rinv * gg;
    }
}
template <int NR> __device__ __forceinline__ void rms_rows_from_bf16(const bf16* XB, int m0, int mstride, int mend, const float* g, float* Y, int lane) {
    u32x2 raw[NR][8];
#pragma unroll
    for (int k = 0; k < NR; ++k) { const int m = m0 + k * mstride; if (m < mend) { const u32x2* xr = (const u32x2*)(XB + (size_t)m * DM) + lane;
#pragma unroll
            for (int j = 0; j < 8; ++j) raw[k][j] = xr[64 * j]; } }
    const f32x4* gr = (const f32x4*)g + lane;
#pragma unroll
    for (int k = 0; k < NR; ++k) { const int m = m0 + k * mstride; if (m < mend) {
            f32x4 v[8]; float s = 0.f;
#pragma unroll
            for (int j = 0; j < 8; ++j) { const u32x2 w = raw[k][j]; v[j] = (f32x4){bf_lo(w.x), bf_hi(w.x), bf_lo(w.y), bf_hi(w.y)}; s += (v[j].x * v[j].x + v[j].y * v[j].y) + (v[j].z * v[j].z + v[j].w * v[j].w); }
            const float r = 1.0f / sqrtf(wave_sum(s) * (1.0f / DM) + 1e-6f);
            f32x4* yo = (f32x4*)(Y + (size_t)m * DM) + lane;
#pragma unroll
            for (int j = 0; j < 8; ++j) { const f32x4 gg = gr[64 * j]; yo[64 * j] = v[j] * r * gg; } } }
}
__device__ __forceinline__ void rms_row_from_bf16(const bf16* xb, const float* g, float* yrow, int lane) {
    const u32x2* xr = (const u32x2*)xb + lane; f32x4 v[8]; float s = 0.f;
#pragma unroll
    for (int j = 0; j < 8; ++j) { const u32x2 w = xr[64 * j]; v[j] = (f32x4){bf_lo(w.x), bf_hi(w.x), bf_lo(w.y), bf_hi(w.y)}; }
#pragma unroll
    for (int j = 0; j < 8; ++j) s += (v[j].x * v[j].x + v[j].y * v[j].y) + (v[j].z * v[j].z + v[j].w * v[j].w);
    const float r = 1.0f / sqrtf(wave_sum(s) * (1.0f / DM) + 1e-6f);
    f32x4* yo = (f32x4*)yrow + lane; const f32x4* gr = (const f32x4*)g + lane;
#pragma unroll
    for (int j = 0; j < 8; ++j) { const f32x4 gg = gr[64 * j]; yo[64 * j] = v[j] * r * gg; }
}
__device__ __forceinline__ void rms_row_f32_inplace(float* xrow, const float* part, int npart, const float* g, int lane) {
    f32x4 v[8]; const float r = 1.0f / sqrtf(load_row_sumsq(v, xrow, xrow, part, npart, lane) * (1.0f / DM) + 1e-6f);
    f32x4* xr = (f32x4*)xrow + lane; const f32x4* gr = (const f32x4*)g + lane;
#pragma unroll
    for (int j = 0; j < 8; ++j) { const f32x4 gg = gr[64 * j]; xr[64 * j] = v[j] * r * gg; }
}

struct KVDesc { const bf16* kb; const bf16* vb; const float* kf; const float* vf; int strideb, stridef, n_f32, n_b16, zero_lo; };
__device__ __forceinline__ int vpos(int key) { return (key & ~31) + (((key & 15) >> 2) << 3) + (key & 3) + (((key >> 4) & 1) << 2); }
template <int D> __device__ __forceinline__ void attn_load_kv(LAS unsigned char* lds, const KVDesc& kv, int tid) {
    constexpr int KSTR = D * 2 + 16, VSTR = 528, CH = D / 8, VT_OFF = 256 * KSTR;
#pragma unroll 1
    for (int idx = tid; idx < 64 * CH; idx += NTHREADS) {
        const int blk = idx >> 6, key0 = ((blk & 3) * 16 + (idx & 15)) * 4, c = (blk >> 2) * 4 + ((idx >> 4) & 3);
        u32x4 kk[4], vv[4];
#pragma unroll
        for (int i = 0; i < 4; ++i) {
            const int key = key0 + i;
            kk[i] = (u32x4){0u, 0u, 0u, 0u}; vv[i] = (u32x4){0u, 0u, 0u, 0u};
            if (key >= kv.zero_lo && key < kv.n_f32 + kv.n_b16) {
                if (key < kv.n_f32) {
                    const f32x4* ks = (const f32x4*)(kv.kf + (size_t)key * kv.stridef + c * 8); const f32x4* vs = (const f32x4*)(kv.vf + (size_t)key * kv.stridef + c * 8);
                    const f32x4 a = ks[0], b = ks[1], e = vs[0], f = vs[1];
                    kk[i].x = pk2(a.x, a.y); kk[i].y = pk2(a.z, a.w); kk[i].z = pk2(b.x, b.y); kk[i].w = pk2(b.z, b.w);
                    vv[i].x = pk2(e.x, e.y); vv[i].y = pk2(e.z, e.w); vv[i].z = pk2(f.x, f.y); vv[i].w = pk2(f.z, f.w);
                } else {
                    kk[i] = *(const u32x4*)(kv.kb + (long)(key - kv.n_f32) * kv.strideb + c * 8); vv[i] = *(const u32x4*)(kv.vb + (long)(key - kv.n_f32) * kv.strideb + c * 8);
                }
            }
        }
#pragma unroll
        for (int i = 0; i < 4; ++i) *(LAS u32x4*)(lds + (key0 + i) * KSTR + c * 16) = kk[i];
        LAS unsigned char* vb = lds + VT_OFF + vpos(key0) * 2;
#pragma unroll
        for (int w = 0; w < 4; ++w) {
            u32x2 lo, hi;
            lo.x = (vv[0][w] & 0xffffu) | (vv[1][w] << 16); lo.y = (vv[2][w] & 0xffffu) | (vv[3][w] << 16);
            hi.x = (vv[0][w] >> 16) | (vv[1][w] & 0xffff0000u); hi.y = (vv[2][w] >> 16) | (vv[3][w] & 0xffff0000u);
            const int r0 = ((c >> 2) << 5) + (((w >> 1) & 1) << 4) + ((c & 3) << 2) + ((2 * w) & 3);
            *(LAS u32x2*)(vb + r0 * VSTR) = lo; *(LAS u32x2*)(vb + (r0 + 1) * VSTR) = hi;
        }
    }
}
template <int D> __device__ __forceinline__ void attn_loadq(bf16x8 (&qf)[D / 32], const bf16* qrow, int lane) {
#pragma unroll
    for (int kk = 0; kk < D / 32; ++kk) qf[kk] = *(const bf16x8*)(qrow + 32 * kk + 8 * (lane >> 4));
}
template <int D, bool BAND> __device__ __forceinline__ void attn16(const LAS unsigned char* lds, const bf16x8 (&qf)[D / 32], bf16* orow, bool row_valid, int qi, bool prev_valid, float sinkl2, int kt_lo, int kt_hi, int lane) {
    constexpr int KSTR = D * 2 + 16, VSTR = 528, NKK = D / 32, NDT = D / 16, VT_OFF = 256 * KSTR;
    const int fr = lane & 15, fq = lane >> 4;
    const float NEGI = -__builtin_inff();
    f32x4 s[16];
#pragma unroll
    for (int kt = 0; kt < 16; ++kt) {
        if (!BAND || (kt >= kt_lo && kt <= kt_hi)) { s[kt] = (f32x4){0.f, 0.f, 0.f, 0.f};
#pragma unroll
            for (int kk = 0; kk < NKK; ++kk) { const bf16x8 kf = *(const LAS bf16x8*)(lds + (16 * kt + fr) * KSTR + (32 * kk + 8 * fq) * 2);
                s[kt] = __builtin_amdgcn_mfma_f32_16x16x32_bf16(kf, qf[kk], s[kt], 0, 0, 0); }
        } else s[kt] = (f32x4){NEGI, NEGI, NEGI, NEGI}; }
    const float cs = (D == 128 ? 0.08838834764831845f : 0.125f) * 1.4426950408889634f;
    const float NEG = -__builtin_inff();
    float mx = NEG;
#pragma unroll
    for (int kt = 0; kt < 16; ++kt)
#pragma unroll
        for (int r = 0; r < 4; ++r) { float v = s[kt][r] * cs;
            if (BAND) { const int kj = 16 * kt + 4 * fq + r; const bool ok = (kj > qi) && (kj <= qi + 128) && (prev_valid || kj >= 128); v = ok ? v : NEG; }
            s[kt][r] = v; mx = fmaxf(mx, v); }
    mx = fmaxf(mx, __shfl_xor(mx, 16)); mx = fmaxf(mx, __shfl_xor(mx, 32));
    if (BAND) mx = fmaxf(mx, sinkl2);
    float sum = 0.f;
#pragma unroll
    for (int kt = 0; kt < 16; ++kt)
#pragma unroll
        for (int r = 0; r < 4; ++r) { const float e = __builtin_amdgcn_exp2f(s[kt][r] - mx); s[kt][r] = e; sum += e; }
    sum += __shfl_xor(sum, 16); sum += __shfl_xor(sum, 32);
    if (BAND) sum += __builtin_amdgcn_exp2f(sinkl2 - mx);
    const float inv = 1.0f / sum;
    f32x4 o[NDT];
#pragma unroll
    for (int dt = 0; dt < NDT; ++dt) o[dt] = (f32x4){0.f, 0.f, 0.f, 0.f};
#pragma unroll
    for (int sl = 0; sl < 8; ++sl) {
        if (BAND && (2 * sl + 1 < kt_lo || 2 * sl > kt_hi)) continue;
        u32x4 pw; pw.x = pk2(s[2 * sl][0], s[2 * sl][1]); pw.y = pk2(s[2 * sl][2], s[2 * sl][3]); pw.z = pk2(s[2 * sl + 1][0], s[2 * sl + 1][1]); pw.w = pk2(s[2 * sl + 1][2], s[2 * sl + 1][3]);
        const bf16x8 pf = __builtin_bit_cast(bf16x8, pw);
#pragma unroll
        for (int dt = 0; dt < NDT; ++dt) { const bf16x8 vf = *(const LAS bf16x8*)(lds + VT_OFF + (16 * dt + fr) * VSTR + (32 * sl + 8 * fq) * 2);
            o[dt] = __builtin_amdgcn_mfma_f32_16x16x32_bf16(vf, pf, o[dt], 0, 0, 0); } }
    if (row_valid) {
#pragma unroll
        for (int k = 0; k < NDT / 2; ++k) {
            u32x4 w; w.x = pk2(o[2 * k][0] * inv, o[2 * k][1] * inv); w.y = pk2(o[2 * k][2] * inv, o[2 * k][3] * inv); w.z = pk2(o[2 * k + 1][0] * inv, o[2 * k + 1][1] * inv); w.w = pk2(o[2 * k + 1][2] * inv, o[2 * k + 1][3] * inv);
            *(u32x4*)(orow + 32 * k + 8 * fq) = w; }
    }
}

__global__ void __launch_bounds__(NTHREADS, 2) fwd_megakernel(Params p) {
    extern __shared__ __attribute__((aligned(16))) unsigned char lds_raw[];
    LAS unsigned char* lds = (LAS unsigned char*)lds_raw;
    cg::grid_group grid = cg::this_grid();
    const int G = gridDim.x, bx = blockIdx.x, NGW = G * NWAVES;
#define PHASE_IDS() const int tid = otid(), lane = tid & 63, wave = __builtin_amdgcn_readfirstlane(tid >> 6), gw = bx * NWAVES + wave; (void)lane; (void)gw
    unsigned char* ws = p.ws;
    float* out = p.out;
    bf16* WIN0 = (bf16*)(ws + WS_WIN0); bf16* WMEM = (bf16*)(ws + WS_WMEM); bf16* WIN1 = (bf16*)(ws + WS_WIN1); bf16* WOUT = (bf16*)(ws + WS_WOUT);
    bf16* WGU = (bf16*)(ws + WS_WGU); bf16* WDN = (bf16*)(ws + WS_WDN); bf16* H = (bf16*)(ws + WS_H); bf16* MEMH = (bf16*)(ws + WS_MEMH);
    bf16* MIX = (bf16*)(ws + WS_MIX); bf16* ZA = (bf16*)(ws + WS_ZA); bf16* MKV = (bf16*)(ws + WS_MKV);
    float* X = out;
    float* PART = (float*)(ws + WS_PART);
    float* RSP = (float*)(ws + WS_RSP);
    float* RS = (float*)(ws + WS_RS);
    constexpr int SNT_OUT = 4, NSL_OUT = (DM / 64) / SNT_OUT, SNT_DN = 8, NSL_DN = (FF / 64) / SNT_DN;
    unsigned* barw = (unsigned*)(ws + WS_BAR);
    volatile LAS unsigned* MISC = (volatile LAS unsigned*)(lds + MISC_OFF);
    { const int t0 = otid(); if (bx == 0) for (int i = t0; i < XCD_BAR_WORDS; i += NTHREADS) barw[i] = 0u; if (t0 < 2) MISC[t0] = 0u; }
    __syncthreads();

    constexpr int I_IN0 = (DM / 64) * (NIN0 / 32), I_MEM = (DM / 64) * (1024 / 32), I_IN1 = (DM / 64) * (NIN1 / 32), I_OUT = (DM / 64) * (DM / 32), I_GU = (DM / 64) * (FF / 32), I_DN = (FF / 64) * (DM / 32);
    constexpr int NP0 = I_IN0 + 2 * I_MEM + I_IN1 + I_OUT + 2 * I_GU + I_DN, NITEMS = NP0 + I_OUT + 2 * I_GU + I_DN;
#ifndef DQ_
#define DQ_ 5
#endif
    constexpr int DQ = DQ_, DEF_A = 76 * 8 * DQ, DEF_B = 84 * 8 * DQ, DEF_C = 182 * 8 * DQ;
    constexpr int DEF0 = (NITEMS - DEF_A - DEF_B - DEF_C) > NP0 ? (NITEMS - DEF_A - DEF_B - DEF_C) : NP0;
    const bool defer = (G == 256);
#define GET_ITEM(it_, T) do { int r = (it_); int mode = 0; (T).gk = nullptr; (T).K = DM; \
            if (r < I_IN0) { (T).W = p.in[I_CWIN]; (T).WT = WIN0; (T).N = NIN0; } \
            else if ((r -= I_IN0) < I_MEM) { (T).W = p.in[I_WMEMKV]; (T).WT = WMEM; (T).N = 1024; } \
            else if ((r -= I_MEM) < I_MEM) { (T).W = p.in[I_WMEMKV] + (size_t)DM * 1024; (T).WT = WMEM + (size_t)1024 * DM; (T).N = 1024; } \
            else if ((r -= I_MEM) < I_IN1) { (T).W = p.in[I_AWIN]; (T).WT = WIN1; (T).N = NIN1; (T).gk = p.in[I_NMIX] + DM; } \
            else if ((r -= I_IN1) < I_OUT) { (T).W = p.in[I_CWOUT]; (T).WT = WOUT; (T).N = DM; } \
            else if ((r -= I_OUT) < I_GU) { (T).W = p.in[I_WGATE]; (T).WT = WGU; (T).N = FF; mode = 1; (T).gk = p.in[I_NFFN]; } \
            else if ((r -= I_GU) < I_GU) { (T).W = p.in[I_WUP]; (T).WT = WGU; (T).N = FF; mode = 2; (T).gk = p.in[I_NFFN]; } \
            else if ((r -= I_GU) < I_DN) { (T).W = p.in[I_WDOWN]; (T).WT = WDN; (T).N = DM; (T).K = FF; } \
            else if ((r -= I_DN) < I_OUT) { (T).W = p.in[I_AWOUT]; (T).WT = WOUT + (size_t)DM * DM; (T).N = DM; } \
            else if ((r -= I_OUT) < I_GU) { (T).W = p.in[I_WGATE] + (size_t)DM * FF; (T).WT = WGU + (size_t)NGU * DM; (T).N = FF; mode = 1; (T).gk = p.in[I_NFFN] + DM; } \
            else if ((r -= I_GU) < I_GU) { (T).W = p.in[I_WUP] + (size_t)DM * FF; (T).WT = WGU + (size_t)NGU * DM; (T).N = FF; mode = 2; (T).gk = p.in[I_NFFN] + DM; } \
            else { r -= I_GU; (T).W = p.in[I_WDOWN] + (size_t)FF * DM; (T).WT = WDN + (size_t)DM * FF; (T).N = DM; (T).K = FF; } \
            const int nblk = (T).N / 32, kb = r / nblk, nb = r % nblk; (T).n0 = 32 * nb; (T).k0 = 64 * kb; \
            (T).d0 = mode == 0 ? (T).n0 : (256 * ((T).n0 >> 7) + ((T).n0 & 127) + (mode == 2 ? 128 : 0)); } while (0)
#define LOCAL_PTRS() const Params* pp_ = (const Params*)__builtin_amdgcn_kernarg_segment_ptr(); asm volatile("" : "+s"(pp_)); const Params& p = *pp_; unsigned char* ws = p.ws; \
        bf16* WIN0 = (bf16*)(ws + WS_WIN0); bf16* WMEM = (bf16*)(ws + WS_WMEM); bf16* WIN1 = (bf16*)(ws + WS_WIN1); bf16* WOUT = (bf16*)(ws + WS_WOUT); bf16* WGU = (bf16*)(ws + WS_WGU); bf16* WDN = (bf16*)(ws + WS_WDN); \
        (void)WIN0; (void)WMEM; (void)WIN1; (void)WOUT; (void)WGU; (void)WDN
#define CONVERT_SIMPLE(first_, stride_, count_, end_) do { LAS float* scr_ = (LAS float*)(lds + wave * 16384); \
            for (int j_ = 0, it = (first_); j_ < (count_) && it < (end_); ++j_, it += (stride_)) { TItem cur; float wv[32]; GET_ITEM(it, cur); titem_load(cur, wv, lane); titem_store(cur, wv, scr_, lane); } } while (0)
#define CONVERT_ITEMS(first_, stride_, count_, end_) do { LAS float* scr_ = (LAS float*)(lds + wave * 16384); \
            TItem cur, nxt; float wv[32], wn[32]; int it = (first_), left = (count_); const int stride = (stride_), end = (end_); \
            if (it < end && left > 0) { GET_ITEM(it, cur); titem_load(cur, wv, lane); } \
            while (it < end && left > 0) { \
                const int itn = it + stride; const bool hn = itn < end && left > 1; \
                if (hn) { GET_ITEM(itn, nxt); titem_load(nxt, wn, lane); } \
                titem_store(cur, wv, scr_, lane); \
                if (hn) { cur = nxt; titem_copy(wv, wn); } \
                it = itn; --left; } } while (0)
    {
        PHASE_IDS();
        CONVERT_ITEMS(gw, NGW, (1 << 30), defer ? DEF0 : NITEMS);

        for (int i = bx * NTHREADS + tid; i < NSR * DM / 4; i += G * NTHREADS) ((f32x4*)(X + (size_t)NPR * DM))[i] = ((const f32x4*)p.in[I_XS])[i];
        for (int i = bx * NTHREADS + tid; i < 4 * MT; i += G * NTHREADS) RS[i] = 0.f;
        for (int m = gw; m < 2048; m += NGW) { const int li = m >> 10, r = m & 1023; rms_row_bf16(p.in[I_MEMP] + (size_t)r * DM, nullptr, nullptr, 0, p.in[I_NMEM] + li * DM, MEMH + (size_t)m * DM, lane); }
        for (int m = gw; m < MT; m += NGW) { const float* xr = m < NPR ? p.in[I_XP] + (size_t)m * DM : p.in[I_XS] + (size_t)(m - NPR) * DM; rms_row_bf16(xr, nullptr, nullptr, 0, p.in[I_NMIX], H + (size_t)m * DM, lane); }
    }
    grid.sync();
    const XcdBarrier xbar = xcd_barrier_post(barw, MISC);

#pragma unroll 1
    for (int li = 0; li < 2; ++li) {
        const int NIN = li ? NIN1 : NIN0;
        const int QMOFF = li ? 2048 : 4608;
        bf16* Z = ZA;
        if (li == 0) {
            pg8::Gemm g{MEMH, WMEM, 2048, 2048, DM}; pg8::MemOrder S{G, (bx + G - (200 % G)) % G};
            pg8::EpiMem E{out + OUT_MK, out + OUT_MV, MKV};
            pg8::gemm_phase<pg8::EpiMem, pg8::MemOrder, true, true>(lds, g, S, E);
        }

        {
            pg8::Gemm g{H, li ? WIN1 : WIN0, MT, NIN, DM}; pg8::StaticOrder S; S.init(MT, NIN, G, bx, DM);
            pg8::EpiZ E{Z, NIN, li ? RS + MT : nullptr};
            pg8::gemm_phase<pg8::EpiZ, pg8::StaticOrder, true, true>(lds, g, S, E);
        }
        if (defer) {
            PHASE_IDS();
            if (li == 0) { const int r = (bx >= 148 && bx < 200) ? bx - 148 : (bx >= 232 ? 52 + bx - 232 : -1);
                if (r >= 0) CONVERT_SIMPLE(DEF0 + r * 8 + wave, 76 * 8, DQ, DEF0 + DEF_A); }
            else if (bx >= 74) CONVERT_SIMPLE(DEF0 + DEF_A + DEF_B + (bx - 74) * 8 + wave, 182 * 8, DQ, NITEMS);
        }

        xcd_barrier(xbar);
        {
            PHASE_IDS();
            for (int u = bx; u < 256; u += G) {
                KVDesc kv; int row0, h, niter; bool valid;
                if (u < 128) { const int b = u >> 5; h = (u >> 3) & 3; const int ch = u & 7;
                    kv.kb = MKV + (size_t)li * 1048576 + (size_t)(b * 256) * 1024 + h * 128; kv.vb = kv.kb + 512; kv.kf = nullptr; kv.vf = nullptr; kv.strideb = 1024; kv.stridef = 0; kv.n_f32 = 0; kv.n_b16 = 256; kv.zero_lo = 0;
                    row0 = b * 2048 + ch * 256 + wave * 32 + (lane & 15); valid = true; niter = 2;
                } else { const int s = u - 128, b = s >> 2; h = s & 3;
                    kv.kf = p.in[I_CMK] + (size_t)((li * 32 + b) * 256) * 512 + h * 128; kv.vf = p.in[I_CMV] + (size_t)((li * 32 + b) * 256) * 512 + h * 128; kv.kb = nullptr; kv.vb = nullptr; kv.strideb = 0; kv.stridef = 512; kv.n_f32 = 256; kv.n_b16 = 0; kv.zero_lo = 0;
                    row0 = NPR + b * 8 + (lane & 7); valid = (lane & 15) < 8; niter = (wave == 0) ? 1 : 0;
                }
                attn_load_kv<128>(lds, kv, tid);
                __syncthreads();
                for (int t = 0; t < niter; ++t) {
                    asm volatile("" ::: "memory");
                    const int row = row0 + 16 * t;
                    bf16x8 qf[4]; attn_loadq<128>(qf, Z + (size_t)row * NIN + QMOFF + h * 128, lane);
                    attn16<128, false>(lds, qf, MIX + (size_t)row * DM + TW + h * 128, valid, 0, true, 0.f, 0, 15, lane);
                }
                __syncthreads();
            }

            if (li == 0) {
                const float* cw = p.in[I_CW];
                for (int item = bx * NTHREADS + tid; item < 1056 * 192; item += G * NTHREADS) {
                    const int run = item / 192, ch0 = (item % 192) * 8;
                    float w0[8], w1[8], w2[8], pm2[8], pm1[8];
#pragma unroll
                    for (int i = 0; i < 8; ++i) { w0[i] = cw[ch0 + i]; w1[i] = cw[TW + ch0 + i]; w2[i] = cw[2 * TW + ch0 + i]; pm2[i] = 0.f; pm1[i] = 0.f; }
                    int row0; bool last; float* so;
                    if (run < 1024) { const int b = run >> 8, t0 = (run & 255) * 8; row0 = b * 2048 + t0; last = (run & 255) == 255; so = out + OUT_CP + (size_t)(b * 2) * TW + ch0;
                        if (t0 > 0) {
                            const bf16* z2 = Z + (size_t)(row0 - 2) * NIN0 + ch0; const bf16* z1 = z2 + NIN0;
                            const u32x4 c2 = *(const u32x4*)(z2 + TW), u2 = *(const u32x4*)(z2 + 2 * TW), c1 = *(const u32x4*)(z1 + TW), u1 = *(const u32x4*)(z1 + 2 * TW);
#pragma unroll
                            for (int i = 0; i < 4; ++i) { pm2[2 * i] = bf_lo(c2[i]) * bf_lo(u2[i]); pm2[2 * i + 1] = bf_hi(c2[i]) * bf_hi(u2[i]); pm1[2 * i] = bf_lo(c1[i]) * bf_lo(u1[i]); pm1[2 * i + 1] = bf_hi(c1[i]) * bf_hi(u1[i]); }
                        }
                    } else { const int b = run - 1024; row0 = NPR + b * 8; last = true; so = out + OUT_CS + (size_t)(b * 2) * TW + ch0;
                        const float* sc = p.in[I_SCONV] + (size_t)(b * 2) * TW + ch0;
#pragma unroll
                        for (int i = 0; i < 8; ++i) { pm2[i] = sc[i]; pm1[i] = sc[TW + i]; }
                    }
#pragma unroll
                    for (int t = 0; t < 8; ++t) {
                        const bf16* zr = Z + (size_t)(row0 + t) * NIN0 + ch0;
                        const u32x4 bb = *(const u32x4*)zr, cc = *(const u32x4*)(zr + TW), uu = *(const u32x4*)(zr + 2 * TW);
                        float tok[8];
#pragma unroll
                        for (int i = 0; i < 4; ++i) {
                            const float cu0 = bf_lo(cc[i]) * bf_lo(uu[i]), cu1 = bf_hi(cc[i]) * bf_hi(uu[i]);
                            tok[2 * i] = bf_lo(bb[i]) * (w0[2 * i] * pm2[2 * i] + w1[2 * i] * pm1[2 * i] + w2[2 * i] * cu0);
                            tok[2 * i + 1] = bf_hi(bb[i]) * (w0[2 * i + 1] * pm2[2 * i + 1] + w1[2 * i + 1] * pm1[2 * i + 1] + w2[2 * i + 1] * cu1);
                            pm2[2 * i] = pm1[2 * i]; pm2[2 * i + 1] = pm1[2 * i + 1]; pm1[2 * i] = cu0; pm1[2 * i + 1] = cu1;
                        }
                        u32x4 w; w.x = pk2(tok[0], tok[1]); w.y = pk2(tok[2], tok[3]); w.z = pk2(tok[4], tok[5]); w.w = pk2(tok[6], tok[7]);
                        *(u32x4*)(MIX + (size_t)(row0 + t) * DM + ch0) = w;
                    }
                    if (last) {
#pragma unroll
                        for (int i = 0; i < 8; ++i) { so[i] = pm2[i]; so[TW + i] = pm1[i]; }
                    }
                }

            } else {
                const float* sinks = p.in[I_SINKS];
                for (int u = bx; u < 384; u += G) {
                    KVDesc kv; int b, kh, blk = 0; const bool isp = u < 256;
                    if (isp) { b = u >> 6; blk = (u >> 2) & 15; kh = u & 3;
                        kv.kb = Z + ((long)(b * 2048 + (blk - 1) * 128)) * NIN1 + TW + 64 * kh; kv.vb = kv.kb + 256; kv.kf = nullptr; kv.vf = nullptr; kv.strideb = NIN1; kv.stridef = 0; kv.n_f32 = 0; kv.n_b16 = 256; kv.zero_lo = blk == 0 ? 128 : 0;
                    } else { const int s = u - 256; b = s >> 2; kh = s & 3;
                        kv.kf = p.in[I_CWK] + (size_t)(b * 128) * 256 + kh * 64; kv.vf = p.in[I_CWV] + (size_t)(b * 128) * 256 + kh * 64; kv.stridef = 256; kv.n_f32 = 128;
                        kv.kb = Z + (size_t)(NPR + b * 8) * NIN1 + TW + 64 * kh; kv.vb = kv.kb + 256; kv.strideb = NIN1; kv.n_b16 = 8; kv.zero_lo = 0;
                    }
                    attn_load_kv<64>(lds, kv, tid);
                    __syncthreads();
                    const int niter = isp ? 6 : (wave < 3 ? 1 : 0);
                    const int qi = isp ? wave * 16 + (lane & 15) : (lane & 7);
                    const int row = isp ? b * 2048 + blk * 128 + qi : NPR + b * 8 + qi;
                    const int hq0 = isp ? 6 * kh : 6 * kh + 2 * wave + ((lane & 15) >> 3);
                    const int kt_lo = isp ? (blk == 0 && wave < 8 ? 8 : wave) : 0, kt_hi = isp ? wave + 8 : 8;
                    for (int it = 0; it < niter; ++it) {
                        asm volatile("" ::: "memory");
                        const int hq = hq0 + it;
                        bf16x8 qc[2]; attn_loadq<64>(qc, Z + (size_t)row * NIN1 + hq * 64, lane);
                        attn16<64, true>(lds, qc, MIX + (size_t)row * DM + hq * 64, true, qi, !isp || blk > 0, sinks[hq] * 1.4426950408889634f, kt_lo, kt_hi, lane);
                    }
                    __syncthreads();
                }

                for (int e = bx * NTHREADS + tid; e < 4 * 128 * 128; e += G * NTHREADS) {
                    const int c = (e & 127) * 4, j = (e >> 7) & 127, b = e >> 14;
                    const u32x2 v = *(const u32x2*)(Z + (size_t)(b * 2048 + 1920 + j) * NIN1 + TW + c);
                    *(f32x4*)(out + (c < 256 ? OUT_WKP : OUT_WVP) + (size_t)(b * 128 + j) * 256 + (c & 255)) = (f32x4){bf_lo(v.x), bf_hi(v.x), bf_lo(v.y), bf_hi(v.y)};
                }
#pragma unroll 4
                for (int e = bx * NTHREADS + tid; e < 32 * 128 * 128; e += G * NTHREADS) {
                    const int c = (e & 127) * 4, j = (e >> 7) & 127, b = e >> 14; f32x4 v;
                    if (j < 120) v = *(const f32x4*)((c < 256 ? p.in[I_CWK] : p.in[I_CWV]) + (size_t)(b * 128 + 8 + j) * 256 + (c & 255));
                    else { const u32x2 w = *(const u32x2*)(Z + (size_t)(NPR + b * 8 + j - 120) * NIN1 + TW + c); v = (f32x4){bf_lo(w.x), bf_hi(w.x), bf_lo(w.y), bf_hi(w.y)}; }
                    *(f32x4*)(out + (c < 256 ? OUT_WKS : OUT_WVS) + (size_t)(b * 128 + j) * 256 + (c & 255)) = v;
                }
            }
        }
        xcd_barrier(xbar);
        {
            pg8::Gemm g{MIX, WOUT + (size_t)li * DM * DM, MT, DM, DM}; pg8::TailOrder S; S.init(G, bx, DM, SNT_OUT);
            pg8::EpiResid E{li ? nullptr : p.in[I_XP], nullptr, PART, H, RSP, true};
            pg8::gemm_phase<pg8::EpiResid, pg8::TailOrder, true, true>(lds, g, S, E);
        }

        xcd_barrier(xbar);
        { PHASE_IDS(); fixup_phase(X, PART, NSL_OUT, H, RS + (size_t)(2 * li) * MT, RSP, (LAS float*)lds, bx, G, tid); }
        xcd_barrier(xbar);
        {
            pg8::Gemm g{H, WGU + (size_t)li * NGU * DM, MT, NGU, DM}; pg8::StaticOrder S; S.init(MT, NGU, G, bx, DM);
            pg8::EpiSwiglu E{ZA, RS + (size_t)(2 * li) * MT};
            pg8::gemm_phase<pg8::EpiSwiglu, pg8::StaticOrder, true, true>(lds, g, S, E);
        }
        if (defer && li == 0 && bx >= 172) { PHASE_IDS(); CONVERT_SIMPLE(DEF0 + DEF_A + (bx - 172) * 8 + wave, 84 * 8, DQ, DEF0 + DEF_A + DEF_B); }

        xcd_barrier(xbar);
        {
            pg8::Gemm g{ZA, WDN + (size_t)li * DM * FF, MT, DM, FF}; pg8::TailOrder S; S.init(G, bx, FF, SNT_DN);
            pg8::EpiResid E{nullptr, nullptr, PART, H, RSP, true};
            pg8::gemm_phase<pg8::EpiResid, pg8::TailOrder, true, true>(lds, g, S, E);
        }

        xcd_barrier(xbar);
        if (li == 0) {
            { PHASE_IDS(); fixup_phase(X, PART, NSL_DN, H, RS + (size_t)MT, RSP, (LAS float*)lds, bx, G, tid); }
            xcd_barrier(xbar);
        }
    }
    { PHASE_IDS(); final_sample_rows(X, PART, NSL_DN, p.in[I_NFINAL], (LAS float*)lds, bx, G, tid); for (int m = gw; m < NPR; m += 4 * NGW) rms_rows_from_bf16<4>(H, m, NGW, NPR, p.in[I_NFINAL], X, lane); }
}

extern "C" void kernel_launch(void* const* d_in, const int* in_sizes, int n_in, void* d_out, int out_size, void* d_ws, size_t ws_size, hipStream_t stream) {
    static int grid = 0;
    if (grid == 0) {
        if (n_in != 22 || (size_t)out_size != OUT_END || ws_size < WS_END) { fprintf(stderr, "kernel_launch: unexpected shapes (n_in %d out %d ws %zu)\n", n_in, out_size, ws_size); grid = -1; return; }
        int dev = 0, cus = 0, per_cu = 0;
        if (hipGetDevice(&dev) != hipSuccess || hipDeviceGetAttribute(&cus, hipDeviceAttributeMultiprocessorCount, dev) != hipSuccess) { grid = -1; return; }
        if (hipFuncSetAttribute((const void*)fwd_megakernel, hipFuncAttributeMaxDynamicSharedMemorySize, LDS_BYTES) != hipSuccess) { fprintf(stderr, "kernel_launch: hipFuncSetAttribute failed\n"); grid = -1; return; }
        if (hipOccupancyMaxActiveBlocksPerMultiprocessor(&per_cu, (const void*)fwd_megakernel, NTHREADS, LDS_BYTES) != hipSuccess || per_cu < 1) { fprintf(stderr, "kernel_launch: occupancy query says %d\n", per_cu); per_cu = 1; }
        (void)hipGetLastError();
        grid = cus * 1;
    }
    if (grid < 0) return;
    Params prm{};
    for (int i = 0; i < 22; ++i) prm.in[i] = (const float*)d_in[i];
    prm.out = (float*)d_out; prm.ws = (unsigned char*)d_ws;
    void* args[] = {&prm};
    hipError_t e = hipLaunchCooperativeKernel((const void*)fwd_megakernel, dim3(grid), dim3(NTHREADS), args, LDS_BYTES, stream);
    if (e != hipSuccess) fprintf(stderr, "kernel_launch: cooperative launch failed: %s (grid %d)\n", hipGetErrorString(e), grid);
}
```

```cpp
#include <hip/hip_runtime.h>
#include <hip/hip_cooperative_groups.h>
#include <cstdio>
#include <cstdint>
namespace cg = cooperative_groups;
namespace pg8 {
#define PG8_LAS __attribute__((address_space(3)))
typedef unsigned short bf16_t;
typedef short bf16x8 __attribute__((ext_vector_type(8)));
typedef float f32x4 __attribute__((ext_vector_type(4)));
typedef unsigned u32x4 __attribute__((ext_vector_type(4)));
typedef unsigned u32x2 __attribute__((ext_vector_type(2)));
constexpr int BM = 256, BK = 64, HALF = 128, HTB = HALF * BK * 2  , STAGE_BYTES = 8 * HTB, NXCD = 8, WGM = 8;

__host__ __device__ __forceinline__ int lds_byte(int r, int c) { const int st = (r >> 4) * 2 + (c >> 5), rr = r & 15, cc = c & 31, ob = rr * 64 + cc * 2; return st * 1024 + (ob ^ (((ob >> 9) & 1) << 5)); }
__host__ __device__ __forceinline__ void stage_rc(int b, int& R, int& C) { const int st = b / 1024, sb = b % 1024, swz = sb ^ (((sb >> 9) & 1) << 5); R = (st >> 1) * 16 + swz / 64; C = (st & 1) * 32 + (swz % 64) / 2; }
__host__ __device__ __forceinline__ int perm32(int rho) { const int n = rho >> 4, i = rho & 15; return 8 * (i >> 2) + 4 * n + (i & 3); }

struct Unit { int pm, pn, k0, nt; };
struct Gemm { const bf16_t* A; const bf16_t* Bt; int M, N, K; };

struct StaticOrder {
    int nM, nN, nwg, G, c, ntf;
    __host__ __device__ void init(int M, int N, int G_, int c_, int K) { nM = M / BM; nN = N / BM; nwg = nM * nN; G = G_; c = c_; ntf = K / BK; }
    __host__ __device__ bool next(int i, Unit& u) const {
        const long L = (long)i * G + c; if (L >= nwg) return false;
        int wgid = (int)L; { const int q = nwg / NXCD, r = nwg % NXCD, xcd = wgid % NXCD, off = wgid / NXCD; wgid = (xcd < r ? xcd * (q + 1) : r * (q + 1) + (xcd - r) * q) + off; }
        const int nig = WGM * nN, gid = wgid / nig, fm = gid * WGM, gsz = (nM - fm) < WGM ? (nM - fm) : WGM;
        u.pm = fm + ((wgid % nig) % gsz); u.pn = (wgid % nig) / gsz; u.k0 = 0; u.nt = ntf; return true;
    }
    __device__ __forceinline__ void a_ready(const Unit&) const {}
    __device__ __forceinline__ void done(const Unit&) const {}
};

__device__ __forceinline__ unsigned cvt_pk_bf16(float lo, float hi) { unsigned r; asm volatile("v_cvt_pk_bf16_f32 %0, %1, %2" : "=v"(r) : "v"(lo), "v"(hi)); return r; }

struct MemOrder {
    int G, c;
    __device__ bool next(int i, Unit& u) const { const int L = i * G + c; if (L >= 32) return false; const int li = L >> 4, r = L & 15; u.pm = li * 4 + (r >> 2); u.pn = li * 4 + (r & 3); u.k0 = 0; u.nt = 32; return true; }
    __device__ __forceinline__ void a_ready(const Unit&) const {}
    __device__ __forceinline__ void done(const Unit&) const {}
};

struct TailOrder {
    StaticOrder main; int G, c, snt, nsub;
    __device__ void init(int G_, int c_, int K, int snt_) { main.init(8192, 2048, G_, c_, K); G = G_; c = c_; snt = snt_; nsub = 8 * ((K / BK) / snt_); }
    __device__ bool next(int i, Unit& u) const {
        const int nm = c < 256 ? (256 - c + G - 1) / G : 0;
        if (i < nm) return main.next(i, u);
        const int Ls = (i - nm) * G + c; if (Ls >= nsub) return false;
        u.pm = 32; u.pn = Ls & 7; u.k0 = (Ls >> 3) * snt; u.nt = snt; return true;
    }
    __device__ __forceinline__ void a_ready(const Unit&) const {}
    __device__ __forceinline__ void done(const Unit&) const {}
};

struct EpiZ {
    static constexpr bool PERM = true, AFTER_DRAIN = false;
    __device__ __forceinline__ void init(f32x4 (&)[2][2][4][2], const Unit&, int, int, int, int) const {}
    bf16_t* O; int ldc; const float* RS;
    __device__ __forceinline__ void operator()(const f32x4 (&acc)[2][2][4][2], const Unit& u, int wr, int wc, int fr, int fq) const {
        const int row0 = u.pm * BM + wr * 64 + fr, col0 = u.pn * BM + wc * 32 + 8 * fq;
        float scv[2][4];
#pragma unroll
        for (int ai = 0; ai < 2; ++ai)
#pragma unroll
            for (int m = 0; m < 4; ++m) scv[ai][m] = RS ? RS[row0 + ai * HALF + m * 16] : 0.f;
#pragma unroll
        for (int ai = 0; ai < 2; ++ai)
#pragma unroll
            for (int m = 0; m < 4; ++m) scv[ai][m] = RS ? __builtin_amdgcn_rsqf(scv[ai][m] * (1.0f / 2048.0f) + 1e-6f) : 1.0f;
        asm volatile("" ::: "memory");
#pragma unroll
        for (int ai = 0; ai < 2; ++ai)
#pragma unroll
            for (int m = 0; m < 4; ++m) { bf16_t* rowp = O + (size_t)(row0 + ai * HALF + m * 16) * ldc + col0;
                const float sc = scv[ai][m];
#pragma unroll
                for (int bj = 0; bj < 2; ++bj) { const f32x4 v0 = acc[ai][bj][m][0] * sc, v1 = acc[ai][bj][m][1] * sc;
                    u32x4 w; w.x = cvt_pk_bf16(v0[0], v0[1]); w.y = cvt_pk_bf16(v0[2], v0[3]); w.z = cvt_pk_bf16(v1[0], v1[1]); w.w = cvt_pk_bf16(v1[2], v1[3]);
                    *(u32x4*)(rowp + bj * HALF) = w; } }
    }
};
struct EpiMem {
    static constexpr bool PERM = true, AFTER_DRAIN = false;
    __device__ __forceinline__ void init(f32x4 (&)[2][2][4][2], const Unit&, int, int, int, int) const {}
    float* outK; float* outV; bf16_t* MKV;
    __device__ __forceinline__ void operator()(const f32x4 (&acc)[2][2][4][2], const Unit& u, int wr, int wc, int fr, int fq) const {
        const int li = u.pm >> 2, row0 = (u.pm & 3) * BM + wr * 64 + fr, ct = (u.pn & 3) * BM, isv = ct >= 512;
        const int col0 = ct + wc * 32 + 8 * fq;
        float* ob = (isv ? outV : outK) + (size_t)li * (1024 * 512) + (col0 - (isv ? 512 : 0));
        bf16_t* bb = MKV + (size_t)li * (1024 * 1024) + col0;
#pragma unroll
        for (int ai = 0; ai < 2; ++ai)
#pragma unroll
            for (int m = 0; m < 4; ++m) { const int row = row0 + ai * HALF + m * 16;
#pragma unroll
                for (int bj = 0; bj < 2; ++bj) { const f32x4 v0 = acc[ai][bj][m][0], v1 = acc[ai][bj][m][1];
                    *(f32x4*)(ob + (size_t)row * 512 + bj * HALF) = v0; *(f32x4*)(ob + (size_t)row * 512 + bj * HALF + 4) = v1;
                    u32x4 w; w.x = cvt_pk_bf16(v0[0], v0[1]); w.y = cvt_pk_bf16(v0[2], v0[3]); w.z = cvt_pk_bf16(v1[0], v1[1]); w.w = cvt_pk_bf16(v1[2], v1[3]);
                    *(u32x4*)(bb + (size_t)row * 1024 + bj * HALF) = w; } }
    }
};
struct EpiResid {
    static constexpr bool PERM = true, AFTER_DRAIN = false;
    __device__ __forceinline__ void init(f32x4 (&acc)[2][2][4][2], const Unit& u, int wr, int wc, int fr, int fq) const {
        if (u.pm == 32) return;
        const int row0 = u.pm * BM + wr * 64 + fr, col0 = u.pn * BM + wc * 32 + 8 * fq;
#pragma unroll
        for (int ai = 0; ai < 2; ++ai)
#pragma unroll
            for (int m = 0; m < 4; ++m) { const size_t off = (size_t)(row0 + ai * HALF + m * 16) * 2048 + col0;
#pragma unroll
                for (int bj = 0; bj < 2; ++bj) {
                    if (baseP) { acc[ai][bj][m][0] = *(const f32x4*)(baseP + off + bj * HALF); acc[ai][bj][m][1] = *(const f32x4*)(baseP + off + bj * HALF + 4); }
                    else { const u32x4 w = *(const u32x4*)(XB + off + bj * HALF);
                        acc[ai][bj][m][0] = (f32x4){__builtin_bit_cast(float, w.x << 16), __builtin_bit_cast(float, w.x & 0xffff0000u), __builtin_bit_cast(float, w.y << 16), __builtin_bit_cast(float, w.y & 0xffff0000u)};
                        acc[ai][bj][m][1] = (f32x4){__builtin_bit_cast(float, w.z << 16), __builtin_bit_cast(float, w.z & 0xffff0000u), __builtin_bit_cast(float, w.w << 16), __builtin_bit_cast(float, w.w & 0xffff0000u)}; } } }
#pragma unroll
        for (int ai = 0; ai < 2; ++ai)
#pragma unroll
            for (int m = 0; m < 4; ++m)
                asm volatile("" : "+v"(acc[ai][0][m][0]), "+v"(acc[ai][0][m][1]), "+v"(acc[ai][1][m][0]), "+v"(acc[ai][1][m][1]));
    }
    const float* baseP; float* X; float* P; bf16_t* XB; float* RS; bool wb;
    __device__ __forceinline__ void operator()(const f32x4 (&acc)[2][2][4][2], const Unit& u, int wr, int wc, int fr, int fq) const {
        const int row0 = u.pm * BM + wr * 64 + fr, col0 = u.pn * BM + wc * 32 + 8 * fq;
        if (u.pm == 32) {
            bf16_t* pb = (bf16_t*)P + (size_t)(u.k0 / u.nt) * (256 * 2048) - (size_t)8192 * 2048;
#pragma unroll
            for (int ai = 0; ai < 2; ++ai)
#pragma unroll
                for (int m = 0; m < 4; ++m) { const size_t off = (size_t)(row0 + ai * HALF + m * 16) * 2048 + col0;
#pragma unroll
                    for (int bj = 0; bj < 2; ++bj) { const f32x4 x0 = acc[ai][bj][m][0], x1 = acc[ai][bj][m][1];
                        u32x4 w; w.x = cvt_pk_bf16(x0[0], x0[1]); w.y = cvt_pk_bf16(x0[2], x0[3]); w.z = cvt_pk_bf16(x1[0], x1[1]); w.w = cvt_pk_bf16(x1[2], x1[3]); *(u32x4*)(pb + off + bj * HALF) = w; } }
            return;
        }
#pragma unroll
        for (int ai = 0; ai < 2; ++ai)
#pragma unroll
            for (int m = 0; m < 4; ++m) { const size_t off = (size_t)(row0 + ai * HALF + m * 16) * 2048 + col0; float ss = 0.f;
#pragma unroll
                for (int bj = 0; bj < 2; ++bj) { const f32x4 x0 = acc[ai][bj][m][0], x1 = acc[ai][bj][m][1];
                    if (X) { *(f32x4*)(X + off + bj * HALF) = x0; *(f32x4*)(X + off + bj * HALF + 4) = x1; }
                    ss += ((x0[0] * x0[0] + x0[1] * x0[1]) + (x0[2] * x0[2] + x0[3] * x0[3])) + ((x1[0] * x1[0] + x1[1] * x1[1]) + (x1[2] * x1[2] + x1[3] * x1[3]));
                    if (wb) { u32x4 w; w.x = cvt_pk_bf16(x0[0], x0[1]); w.y = cvt_pk_bf16(x0[2], x0[3]); w.z = cvt_pk_bf16(x1[0], x1[1]); w.w = cvt_pk_bf16(x1[2], x1[3]); *(u32x4*)(XB + off + bj * HALF) = w; } }
                ss += __shfl_xor(ss, 16); ss += __shfl_xor(ss, 32);
                if (fq == 0) RS[(size_t)(u.pn * 4 + wc) * 8448 + row0 + ai * HALF + m * 16] = ss;
                asm volatile("" ::: "memory"); }
    }
};
struct EpiSwiglu {
    static constexpr bool PERM = true, AFTER_DRAIN = false;
    __device__ __forceinline__ void init(f32x4 (&)[2][2][4][2], const Unit&, int, int, int, int) const {}
    bf16_t* O; const float* RS;
    __device__ __forceinline__ void operator()(const f32x4 (&acc)[2][2][4][2], const Unit& u, int wr, int wc, int fr, int fq) const {
        const int row0 = u.pm * BM + wr * 64 + fr, col0 = u.pn * HALF + wc * 32 + 8 * fq;
        float scv[2][4];
#pragma unroll
        for (int ai = 0; ai < 2; ++ai)
#pragma unroll
            for (int m = 0; m < 4; ++m) scv[ai][m] = RS[row0 + ai * HALF + m * 16];
#pragma unroll
        for (int ai = 0; ai < 2; ++ai)
#pragma unroll
            for (int m = 0; m < 4; ++m) scv[ai][m] = __builtin_amdgcn_rsqf(scv[ai][m] * (1.0f / 2048.0f) + 1e-6f);
        asm volatile("" ::: "memory");
#pragma unroll
        for (int ai = 0; ai < 2; ++ai)
#pragma unroll
            for (int m = 0; m < 4; ++m) { bf16_t* rowp = O + (size_t)(row0 + ai * HALF + m * 16) * 5632 + col0;
                float r[8]; const float sc = scv[ai][m];
#pragma unroll
                for (int n = 0; n < 2; ++n)
#pragma unroll
                    for (int j = 0; j < 4; ++j) { const float g = acc[ai][0][m][n][j] * sc, up = acc[ai][1][m][n][j] * sc;
                        const float e = __builtin_amdgcn_exp2f(g * -1.4426950408889634f); r[n * 4 + j] = g * __builtin_amdgcn_rcpf(1.0f + e) * up; }
                u32x4 w; w.x = cvt_pk_bf16(r[0], r[1]); w.y = cvt_pk_bf16(r[2], r[3]); w.z = cvt_pk_bf16(r[4], r[5]); w.w = cvt_pk_bf16(r[6], r[7]);
                *(u32x4*)rowp = w; }
    }
};

template <class Epi, class Sched, bool ALIGN_EPI = false, bool SP2 = false>
__device__ __forceinline__ void gemm_phase(PG8_LAS unsigned char* lds, const Gemm g, const Sched& S, const Epi& E) {
    int tid_ = threadIdx.x; asm volatile("" : "+v"(tid_));
    const int tid = tid_, wid = __builtin_amdgcn_readfirstlane(tid >> 6), lane = tid & 63, wr = wid >> 2, wc = wid & 3, fr = lane & 15, fq = lane >> 4;
    const int K = g.K;
    unsigned voffA[2], voffB[2];
#pragma unroll
    for (int i = 0; i < 2; ++i) { int R, C; stage_rc(tid * 16 + i * 8192, R, C); const int Rb = Epi::PERM ? ((R & ~31) + perm32(R & 31)) : R;
        voffA[i] = (unsigned)(R * K + C) * 2u; voffB[i] = (unsigned)(Rb * K + C) * 2u; }
    const size_t kstep = (size_t)(BK * 2);
    const size_t hstep = (size_t)HALF * K * 2;
    const size_t tstep = 2 * hstep;
    const unsigned ldsw = (unsigned)wid * 1024u;
    const int aoff = lds_byte(wr * 64 + fr, fq * 8), boff = lds_byte(wc * 32 + fr, fq * 8);
#define PG8_SA(b, h) (((b) * 2 + (h)) * HTB)
#define PG8_SB(b, h) ((4 + (b) * 2 + (h)) * HTB)
#define PG8_STAGE(bufoff, gbase, voff) do { _Pragma("unroll") for (int _i = 0; _i < 2; ++_i) \
        __builtin_amdgcn_global_load_lds((const unsigned*)((const char*)(gbase) + (voff)[_i]), (PG8_LAS unsigned*)(lds + (bufoff) + ldsw + _i * 8192), 16, 0, 0); } while (0)
#define PG8_LDA(dst, b, h) do { _Pragma("unroll") for (int m = 0; m < 4; ++m) _Pragma("unroll") for (int k = 0; k < 2; ++k) dst[m][k] = *(const PG8_LAS bf16x8*)(lds + PG8_SA(b, h) + aoff + m * 2048 + k * 1024); } while (0)
#define PG8_LDB(dst, b, h) do { _Pragma("unroll") for (int n = 0; n < 2; ++n) _Pragma("unroll") for (int k = 0; k < 2; ++k) dst[n][k] = *(const PG8_LAS bf16x8*)(lds + PG8_SB(b, h) + boff + n * 2048 + k * 1024); } while (0)
#define PG8_MMA(ai, bj, At, Bt) do { __builtin_amdgcn_s_setprio(1); _Pragma("unroll") for (int m = 0; m < 4; ++m) _Pragma("unroll") for (int n = 0; n < 2; ++n) _Pragma("unroll") for (int k = 0; k < 2; ++k) \
        acc[ai][bj][m][n] = __builtin_amdgcn_mfma_f32_16x16x32_bf16(Bt[n][k], At[m][k], acc[ai][bj][m][n], 0, 0, 0); __builtin_amdgcn_s_setprio(0); } while (0)
#define PG8_WAIT_V(n) asm volatile("s_waitcnt vmcnt(" #n ")" ::: "memory")
#define PG8_WAIT_L(n) asm volatile("s_waitcnt lgkmcnt(" #n ")" ::: "memory")
#define PG8_BAR __builtin_amdgcn_s_barrier()
#define PG8_SCHED __builtin_amdgcn_sched_barrier(0)
    Unit cur, nxt; int ui = 0;
    if (!S.next(0, cur)) return;
    f32x4 acc[2][2][4][2];
#pragma unroll
    for (int a = 0; a < 2; ++a)
#pragma unroll
        for (int b = 0; b < 2; ++b)
#pragma unroll
            for (int m = 0; m < 4; ++m)
#pragma unroll
                for (int n = 0; n < 2; ++n) acc[a][b][m][n] = (f32x4){0.f, 0.f, 0.f, 0.f};
    E.init(acc, cur, wr, wc, fr, fq);
    bf16x8 At[4][2], B0[2][2], B1[2][2];
    const char* cA = (const char*)g.A + (size_t)cur.pm * tstep + (size_t)cur.k0 * kstep; const char* cB = (const char*)g.Bt + (size_t)cur.pn * tstep + (size_t)cur.k0 * kstep;
    S.a_ready(cur);
    if constexpr (SP2) {
        PG8_STAGE(PG8_SB(0, 0), cB, voffB); PG8_STAGE(PG8_SB(0, 1), cB + hstep, voffB); PG8_STAGE(PG8_SA(0, 0), cA, voffA); PG8_STAGE(PG8_SA(0, 1), cA + hstep, voffA);
        if (wr == 1) PG8_BAR;
        PG8_WAIT_V(2); PG8_BAR;
        PG8_STAGE(PG8_SB(1, 0), cB + kstep, voffB); PG8_STAGE(PG8_SA(1, 0), cA + kstep, voffA); PG8_STAGE(PG8_SB(1, 1), cB + hstep + kstep, voffB);
        PG8_WAIT_V(6); PG8_BAR;
    } else {
        PG8_STAGE(PG8_SB(0, 0), cB, voffB); PG8_STAGE(PG8_SA(0, 0), cA, voffA); PG8_STAGE(PG8_SB(0, 1), cB + hstep, voffB); PG8_STAGE(PG8_SA(0, 1), cA + hstep, voffA);
        if (wr == 1) PG8_BAR;
        PG8_WAIT_V(4); PG8_BAR;
        PG8_STAGE(PG8_SB(1, 0), cB + kstep, voffB); PG8_STAGE(PG8_SA(1, 0), cA + kstep, voffA); PG8_STAGE(PG8_SB(1, 1), cB + hstep + kstep, voffB);
        PG8_WAIT_V(6); PG8_BAR;
    }
    for (;;) {
        const bool has_next = S.next(ui + 1, nxt);
        const char* nA = has_next ? (const char*)g.A + (size_t)nxt.pm * tstep + (size_t)nxt.k0 * kstep : cA; const char* nB = has_next ? (const char*)g.Bt + (size_t)nxt.pn * tstep + (size_t)nxt.k0 * kstep : cB;
        const int nt = cur.nt;
        for (int t = 0; t < nt; t += 2) {
            const bool last = (t == nt - 2);
            const char* a1 = cA + (size_t)(t + 1) * kstep;
            const char* a2 = last ? nA : cA + (size_t)(t + 2) * kstep; const char* b2 = last ? nB : cB + (size_t)(t + 2) * kstep;
            const char* a3 = a2 + kstep; const char* b3 = b2 + kstep;
            if (last && has_next) S.a_ready(nxt);
            if constexpr (SP2) {
            PG8_LDB(B0, 0, 0); PG8_LDB(B1, 0, 1); PG8_SCHED; PG8_LDA(At, 0, 0); PG8_STAGE(PG8_SA(1, 1), a1 + hstep, voffA);
            PG8_WAIT_V(8); PG8_WAIT_L(0); PG8_BAR; PG8_MMA(0, 0, At, B0); PG8_MMA(0, 1, At, B1); PG8_BAR; PG8_SCHED;
            PG8_LDA(At, 0, 1); PG8_STAGE(PG8_SB(0, 0), b2, voffB); PG8_STAGE(PG8_SB(0, 1), b2 + hstep, voffB); PG8_STAGE(PG8_SA(0, 0), a2, voffA);
            PG8_WAIT_V(8); PG8_WAIT_L(0); PG8_BAR; PG8_MMA(1, 0, At, B0); PG8_MMA(1, 1, At, B1); PG8_BAR; PG8_SCHED;
            PG8_LDB(B0, 1, 0); PG8_LDB(B1, 1, 1); PG8_SCHED; PG8_LDA(At, 1, 0); PG8_STAGE(PG8_SA(0, 1), a2 + hstep, voffA);
            PG8_WAIT_V(8); PG8_WAIT_L(0); PG8_BAR; PG8_MMA(0, 0, At, B0); PG8_MMA(0, 1, At, B1); PG8_BAR; PG8_SCHED;
            PG8_LDA(At, 1, 1); PG8_STAGE(PG8_SB(1, 0), b3, voffB); PG8_STAGE(PG8_SB(1, 1), b3 + hstep, voffB); PG8_STAGE(PG8_SA(1, 0), a3, voffA);
            PG8_WAIT_V(8); PG8_WAIT_L(0); PG8_BAR; PG8_MMA(1, 0, At, B0); PG8_MMA(1, 1, At, B1); PG8_BAR; PG8_SCHED;
            } else {
            PG8_LDB(B0, 0, 0); PG8_SCHED; PG8_LDA(At, 0, 0); PG8_STAGE(PG8_SA(1, 1), a1 + hstep, voffA);
            PG8_WAIT_L(8); PG8_BAR; PG8_WAIT_L(0); PG8_MMA(0, 0, At, B0); PG8_BAR; PG8_SCHED;
            PG8_LDB(B1, 0, 1); PG8_STAGE(PG8_SB(0, 0), b2, voffB);
            PG8_BAR; PG8_WAIT_L(0); PG8_MMA(0, 1, At, B1); PG8_BAR;
            PG8_LDA(At, 0, 1); PG8_STAGE(PG8_SA(0, 0), a2, voffA);
            PG8_BAR; PG8_WAIT_L(0); PG8_MMA(1, 0, At, B0); PG8_BAR; PG8_SCHED;
            PG8_STAGE(PG8_SB(0, 1), b2 + hstep, voffB);
            PG8_WAIT_V(6); PG8_BAR; PG8_MMA(1, 1, At, B1); PG8_BAR;
            PG8_LDB(B0, 1, 0); PG8_SCHED; PG8_LDA(At, 1, 0); PG8_STAGE(PG8_SA(0, 1), a2 + hstep, voffA);
            PG8_WAIT_L(8); PG8_BAR; PG8_WAIT_L(0); PG8_MMA(0, 0, At, B0); PG8_BAR; PG8_SCHED;
            PG8_LDB(B1, 1, 1); PG8_STAGE(PG8_SB(1, 0), b3, voffB);
            PG8_BAR; PG8_WAIT_L(0); PG8_MMA(0, 1, At, B1); PG8_BAR;
            PG8_LDA(At, 1, 1); PG8_STAGE(PG8_SA(1, 0), a3, voffA);
            PG8_BAR; PG8_WAIT_L(0); PG8_MMA(1, 0, At, B0); PG8_BAR; PG8_SCHED;
            PG8_STAGE(PG8_SB(1, 1), b3 + hstep, voffB);
            PG8_WAIT_V(6); PG8_BAR; PG8_MMA(1, 1, At, B1); PG8_BAR;
            }
        }
        if constexpr (ALIGN_EPI) { if (wr == 0) PG8_BAR; }
        if constexpr (!Epi::AFTER_DRAIN) { E(acc, cur, wr, wc, fr, fq); S.done(cur); }
        if (!has_next) break;
#pragma unroll
        for (int a = 0; a < 2; ++a)
#pragma unroll
            for (int b = 0; b < 2; ++b)
#pragma unroll
                for (int m = 0; m < 4; ++m)
#pragma unroll
                    for (int n = 0; n < 2; ++n) acc[a][b][m][n] = (f32x4){0.f, 0.f, 0.f, 0.f};
        E.init(acc, nxt, wr, wc, fr, fq);
        cur = nxt; cA = nA; cB = nB; ++ui;
        if constexpr (ALIGN_EPI) { if (wr == 1) PG8_BAR; }
    }
    PG8_WAIT_V(0);
    if constexpr (!ALIGN_EPI) { if (wr == 0) PG8_BAR; }
    PG8_BAR;
    if constexpr (Epi::AFTER_DRAIN) { E.fused(acc, cur, wr, wc, fr, fq, lds, wid, lane); S.done(cur); }
#undef PG8_SA
#undef PG8_SB
#undef PG8_STAGE
#undef PG8_LDA
#undef PG8_LDB
#undef PG8_MMA
#undef PG8_WAIT_V
#undef PG8_WAIT_L
#undef PG8_BAR
#undef PG8_SCHED
}
}

#define LAS __attribute__((address_space(3)))
typedef unsigned short bf16;
typedef short bf16x8 __attribute__((ext_vector_type(8)));
typedef float f32x4 __attribute__((ext_vector_type(4)));
typedef unsigned u32x4 __attribute__((ext_vector_type(4)));
typedef unsigned u32x2 __attribute__((ext_vector_type(2)));
constexpr int DM = 2048, NPR = 8192, NSR = 256, MT = NPR + NSR, FF = 5632, TW = 1536, NIN0 = 5120, NIN1 = 2560, NGU = 2 * FF;
constexpr int NTHREADS = 512, NWAVES = 8;
constexpr int LDS_BYTES = 147456, MISC_OFF = LDS_BYTES - 64;
constexpr size_t OUT_CP = (size_t)MT * DM, OUT_CS = OUT_CP + 12288, OUT_WKP = OUT_CS + 98304, OUT_WVP = OUT_WKP + 131072, OUT_WKS = OUT_WVP + 131072,
                 OUT_WVS = OUT_WKS + 1048576, OUT_MK = OUT_WVS + 1048576, OUT_MV = OUT_MK + 1048576, OUT_END = OUT_MV + 1048576;
constexpr size_t MiB = 1u << 20;
constexpr size_t WS_WIN0 = 0, WS_WMEM = 20 * MiB, WS_WIN1 = 28 * MiB, WS_WOUT = 38 * MiB, WS_WGU = 54 * MiB, WS_WDN = 142 * MiB, WS_H = 186 * MiB, WS_MEMH = 219 * MiB,
                 WS_MIX = 227 * MiB, WS_ZA = 260 * MiB, WS_MKV = 351 * MiB, WS_BAR = 355 * MiB, WS_RS = 379 * MiB, WS_RSP = 380 * MiB, WS_PART = 384 * MiB, WS_END = 430 * MiB;
static_assert((size_t)NIN0 * DM * 2 <= WS_WMEM - WS_WIN0 && (size_t)2 * 1024 * DM * 2 <= WS_WIN1 - WS_WMEM && (size_t)NIN1 * DM * 2 <= WS_WOUT - WS_WIN1 && (size_t)2 * DM * DM * 2 <= WS_WGU - WS_WOUT &&
              (size_t)2 * NGU * DM * 2 <= WS_WDN - WS_WGU && (size_t)2 * DM * FF * 2 <= WS_H - WS_WDN && (size_t)MT * DM * 2 <= WS_MEMH - WS_H && (size_t)2 * 1024 * DM * 2 <= WS_MIX - WS_MEMH &&
              (size_t)MT * DM * 2 <= WS_ZA - WS_MIX && (size_t)MT * FF * 2 <= WS_MKV - WS_ZA && (size_t)MT * NIN0 * 2 <= WS_MKV - WS_ZA && (size_t)2 * 1024 * 1024 * 2 <= WS_BAR - WS_MKV, "d_ws map");

struct Params { const float* in[22]; float* out; unsigned char* ws; };
enum { I_XP = 0, I_XS, I_MEMP, I_SCONV, I_CWK, I_CWV, I_CMK, I_CMV, I_NMIX, I_NMEM, I_WMEMKV, I_NFFN, I_WGATE, I_WUP, I_WDOWN, I_CWIN, I_CW, I_CWOUT, I_AWIN, I_SINKS, I_AWOUT, I_NFINAL };

__device__ __forceinline__ unsigned f2bf(float f) { unsigned u = __builtin_bit_cast(unsigned, f); return (u + 0x7fffu + ((u >> 16) & 1u)) >> 16; }
__device__ __forceinline__ unsigned pk2(float lo, float hi) { return f2bf(lo) | (f2bf(hi) << 16); }
__device__ __forceinline__ float bf_lo(unsigned w) { return __builtin_bit_cast(float, w << 16); }
__device__ __forceinline__ float bf_hi(unsigned w) { return __builtin_bit_cast(float, w & 0xffff0000u); }
__device__ __forceinline__ float wave_sum(float v) {
#pragma unroll
    for (int o = 1; o < 64; o <<= 1) v += __shfl_xor(v, o);
    return v;
}
#define LDS_WAIT() asm volatile("s_waitcnt lgkmcnt(0)" ::: "memory")
__device__ __forceinline__ int otid() { int t = threadIdx.x; asm volatile("" : "+v"(t)); return t; }

#define XB_TMO      128
#define XB_XCNT(j)  (256  + 64 * (j))
#define XB_XSUB(j)  (1280 + 64 * (j))
#define XB_XGEN(j)  (2304 + 64 * (j))
#define XB_TOP      3328
#define XB_TOPGEN   3392
#define XCD_BAR_WORDS 3456
#define XB_SPIN_CAP (1u << 18)

__device__ __forceinline__ unsigned xb_ld(unsigned* p)              { return __hip_atomic_load(p, __ATOMIC_RELAXED, __HIP_MEMORY_SCOPE_AGENT); }
__device__ __forceinline__ unsigned xb_add(unsigned* p, unsigned v) { return __hip_atomic_fetch_add(p, v, __ATOMIC_RELAXED, __HIP_MEMORY_SCOPE_AGENT); }
__device__ __forceinline__ unsigned xb_xcc_id() { return (unsigned)__builtin_amdgcn_s_getreg((3 << 11) | 20) & 0xFu; }
#define XB_SPIN(cond, bar) do { unsigned _sp = 0; while (cond) { __builtin_amdgcn_s_sleep(1); \
    if ((++_sp & 255u) == 0u) { if (xb_ld(&(bar)[XB_TMO])) break; if (_sp > XB_SPIN_CAP) { atomicAdd(&(bar)[XB_TMO], 1u); break; } } } } while (0)

struct XcdBarrier {
    unsigned* bar; unsigned x;
    volatile LAS unsigned* st;
};

__device__ __forceinline__ XcdBarrier xcd_barrier_post(unsigned* bar, volatile LAS unsigned* st) {
    XcdBarrier b; b.bar = bar; b.x = xb_xcc_id(); b.st = st;
    if (threadIdx.x == 0) (void)xb_add(&bar[XB_XCNT(b.x)], 1u);
    return b;
}
__device__ __forceinline__ void xcd_barrier_complete(unsigned* bar, unsigned x, unsigned& nloc, unsigned& nx) {
    const unsigned G = gridDim.x * gridDim.y * gridDim.z;
    unsigned sum, cnt, mine, sp = 0u;
    for (;;) {
        sum = 0u; cnt = 0u; mine = 0u;
#pragma unroll
        for (unsigned j = 0; j < 16; ++j) { const unsigned c = xb_ld(&bar[XB_XCNT(j)]); sum += c; cnt += (c > 0u) ? 1u : 0u; mine = (j == x) ? c : mine; }
        if (sum == G) break;
        __builtin_amdgcn_s_sleep(1);
        if ((++sp & 255u) == 0u) { if (xb_ld(&bar[XB_TMO])) break; if (sp > XB_SPIN_CAP) { atomicAdd(&bar[XB_TMO], 1u); break; } }
    }
    nloc = mine > 0u ? mine : 1u; nx = cnt > 0u ? cnt : 1u;
}

__device__ __forceinline__ void xcd_barrier(const XcdBarrier& b) {
    asm volatile("s_waitcnt vmcnt(0)" ::: "memory");
    __syncthreads();
    if (threadIdx.x == 0) {
        unsigned* bar = b.bar;
        __builtin_amdgcn_s_waitcnt(0);
        unsigned nloc = b.st[0], nx = b.st[1];
        if (nloc == 0u) { xcd_barrier_complete(bar, b.x, nloc, nx); b.st[0] = nloc; b.st[1] = nx; }
        const unsigned old = xb_add(&bar[XB_XSUB(b.x)], 1u);
        const unsigned gen = old / nloc;
        if (old + 1u == (gen + 1u) * nloc) {
            __builtin_amdgcn_fence(__ATOMIC_RELEASE, "agent");
            asm volatile("s_waitcnt vmcnt(0)" ::: "memory");
            const unsigned og = xb_add(&bar[XB_TOP], 1u);
            const unsigned tg = og / nx;
            if (og + 1u == (tg + 1u) * nx) xb_add(&bar[XB_TOPGEN], 1u);
            else XB_SPIN(xb_ld(&bar[XB_TOPGEN]) == tg, bar);
            __builtin_amdgcn_fence(__ATOMIC_ACQUIRE, "agent");
            xb_add(&bar[XB_XGEN(b.x)], 1u);
            asm volatile("s_waitcnt vmcnt(0)" ::: "memory");
        } else {
            XB_SPIN(xb_ld(&bar[XB_XGEN(b.x)]) == gen, bar);
            __builtin_amdgcn_fence(__ATOMIC_ACQUIRE, "agent");
            asm volatile("s_waitcnt vmcnt(0)" ::: "memory");
        }
    }
    __syncthreads();
}

struct TItem { const float* W; bf16* WT; const float* gk; int K, N, k0, n0, d0; };
__device__ __forceinline__ void titem_load(const TItem& t, float (&wv)[32], int lane) {
#pragma unroll
    for (int i = 0; i < 32; ++i) wv[i] = t.W[(size_t)(t.k0 + 2 * i + (lane >> 5)) * t.N + t.n0 + (lane & 31)];
}
__device__ __forceinline__ void titem_copy(float (&d)[32], const float (&s)[32]) {
#pragma unroll
    for (int i = 0; i < 32; ++i) d[i] = s[i];
}
__device__ __forceinline__ void titem_store(const TItem& t, const float (&wv)[32], LAS float* scr, int lane) {
    const int c = lane & 7;
    f32x4 ga = (f32x4){1.f, 1.f, 1.f, 1.f}, gb = ga;
    if (t.gk) { ga = *(const f32x4*)(t.gk + t.k0 + 8 * c); gb = *(const f32x4*)(t.gk + t.k0 + 8 * c + 4); }
#pragma unroll
    for (int i = 0; i < 32; ++i) scr[(2 * i + (lane >> 5)) * 33 + (lane & 31)] = wv[i];
    LDS_WAIT(); asm volatile("" ::: "memory");
#pragma unroll
    for (int j = 0; j < 4; ++j) { const int n = (lane >> 3) + 8 * j; const LAS float* s = scr + (8 * c) * 33 + n;
        u32x4 o; o.x = pk2(s[0 * 33] * ga.x, s[1 * 33] * ga.y); o.y = pk2(s[2 * 33] * ga.z, s[3 * 33] * ga.w); o.z = pk2(s[4 * 33] * gb.x, s[5 * 33] * gb.y); o.w = pk2(s[6 * 33] * gb.z, s[7 * 33] * gb.w);
        *(u32x4*)(t.WT + (size_t)(t.d0 + n) * t.K + t.k0 + 8 * c) = o; }
    LDS_WAIT(); asm volatile("" ::: "memory");
}
constexpr size_t PSTRIDE = (size_t)256 * 2048;
__device__ __forceinline__ float load_row_sumsq(f32x4 (&v)[8], const float* xrow, float* xw, const float* part, int npart, int lane) {
    const f32x4* xr = (const f32x4*)xrow + lane; float s = 0.f;
#pragma unroll
    for (int j = 0; j < 8; ++j) v[j] = xr[64 * j];
    if (npart > 0) {
        for (int q = 0; q < npart; ++q) { const f32x4* pr = (const f32x4*)(part + (size_t)q * PSTRIDE) + lane;
#pragma unroll
            for (int j = 0; j < 8; ++j) v[j] += pr[64 * j]; }
        f32x4* xo = (f32x4*)xw + lane;
#pragma unroll
        for (int j = 0; j < 8; ++j) xo[64 * j] = v[j];
    }
#pragma unroll
    for (int j = 0; j < 8; ++j) s += (v[j].x * v[j].x + v[j].y * v[j].y) + (v[j].z * v[j].z + v[j].w * v[j].w);
    return wave_sum(s);
}
__device__ __forceinline__ void rms_row_bf16(const float* xrow, float* xw, const float* part, int npart, const float* g, bf16* orow, int lane) {
    f32x4 v[8]; const float r = 1.0f / sqrtf(load_row_sumsq(v, xrow, xw, part, npart, lane) * (1.0f / DM) + 1e-6f);
    const f32x4* gr = (const f32x4*)g + lane; u32x2* o8 = (u32x2*)orow + lane;
#pragma unroll
    for (int j = 0; j < 8; ++j) { const f32x4 gg = gr[64 * j]; u32x2 w; w.x = pk2(v[j].x * r * gg.x, v[j].y * r * gg.y); w.y = pk2(v[j].z * r * gg.z, v[j].w * r * gg.w); o8[64 * j] = w; }
}
__device__ __forceinline__ void fixup_phase(float* X, const float* part, int npart, bf16* XB, float* RS, const float* RSP, LAS float* red, int bx, int G, int tid) {
    const int lane = tid & 63, wave = tid >> 6;
    for (int r = bx; r < NSR; r += G) {
        const size_t o = (size_t)(NPR + r) * DM + wave * 256 + lane * 4;
        f32x4 v = *(const f32x4*)(X + o);
        const bf16* pp = (const bf16*)part + (size_t)r * DM + wave * 256 + lane * 4;
        f32x4 q[22];
#pragma unroll
        for (int i = 0; i < 22; ++i) { if (i < npart) { const u32x2 w = *(const u32x2*)(pp + (size_t)i * PSTRIDE); q[i] = (f32x4){bf_lo(w.x), bf_hi(w.x), bf_lo(w.y), bf_hi(w.y)}; } else q[i] = (f32x4){0.f, 0.f, 0.f, 0.f}; }
#pragma unroll
        for (int i = 0; i < 22; ++i) v += q[i];
        *(f32x4*)(X + o) = v;
        u32x2 w; w.x = pk2(v.x, v.y); w.y = pk2(v.z, v.w); *(u32x2*)(XB + o) = w;
        const float ss = wave_sum((v.x * v.x + v.y * v.y) + (v.z * v.z + v.w * v.w));
        __syncthreads();
        if (lane == 0) red[wave] = ss;
        __syncthreads();
        if (tid == 0) RS[NPR + r] = ((red[0] + red[1]) + (red[2] + red[3])) + ((red[4] + red[5]) + (red[6] + red[7]));
    }
    for (int i = bx * NTHREADS + tid; i < NPR * 16; i += G * NTHREADS) {
        const int row = i >> 4, sub = i & 15;
        float s = RSP[(size_t)sub * MT + row] + RSP[(size_t)(sub + 16) * MT + row];
        s += __shfl_xor(s, 1); s += __shfl_xor(s, 2); s += __shfl_xor(s, 4); s += __shfl_xor(s, 8);
        if (sub == 0) RS[row] = s;
    }
}
__device__ __forceinline__ void final_sample_rows(float* X, const float* part, int npart, const float* g, LAS float* red, int bx, int G, int tid) {
    const int lane = tid & 63, wave = tid >> 6;
    for (int r = bx; r < NSR; r += G) {
        const size_t o = (size_t)(NPR + r) * DM + wave * 256 + lane * 4;
        f32x4 v = *(const f32x4*)(X + o);
        const bf16* pp = (const bf16*)part + (size_t)r * DM + wave * 256 + lane * 4;
        f32x4 q[22];
#pragma unroll
        for (int i = 0; i < 22; ++i) { if (i < npart) { const u32x2 w = *(const u32x2*)(pp + (size_t)i * PSTRIDE); q[i] = (f32x4){bf_lo(w.x), bf_hi(w.x), bf_lo(w.y), bf_hi(w.y)}; } else q[i] = (f32x4){0.f, 0.f, 0.f, 0.f}; }
        const f32x4 gg = *(const f32x4*)(g + wave * 256 + lane * 4);
#pragma unroll
        for (int i = 0; i < 22; ++i) v += q[i];
        const float ss = wave_sum((v.x * v.x + v.y * v.y) + (v.z * v.z + v.w * v.w));
        __syncthreads();
        if (lane == 0) red[wave] = ss;
        __syncthreads();
        const float tot = ((red[0] + red[1]) + (red[2] + red[3])) + ((red[4] + red[5]) + (red[6] + red[7]));
        const float rinv = 1.0f / sqrtf(tot * (1.0f / DM) + 1e-6f);
        *(f32x4*)(X + o) = v * rinv * gg;
    }
}
template <int NR> __device__ __forceinline__ void rms_rows_from_bf16(const bf16* XB, int m0, int mstride, int mend, const float* g, float* Y, int lane) {
    u32x2 raw[NR][8];
#pragma unroll
    for (int k = 0; k < NR; ++k) { const int m = m0 + k * mstride; if (m < mend) { const u32x2* xr = (const u32x2*)(XB + (size_t)m * DM) + lane;
#pragma unroll
            for (int j = 0; j < 8; ++j) raw[k][j] = xr[64 * j]; } }
    const f32x4* gr = (const f32x4*)g + lane;
#pragma unroll
    for (int k = 0; k < NR; ++k) { const int m = m0 + k * mstride; if (m < mend) {
            f32x4 v[8]; float s = 0.f;
#pragma unroll
            for (int j = 0; j < 8; ++j) { const u32x2 w = raw[k][j]; v[j] = (f32x4){bf_lo(w.x), bf_hi(w.x), bf_lo(w.y), bf_hi(w.y)}; s += (v[j].x * v[j].x + v[j].y * v[j].y) + (v[j].z * v[j].z + v[j].w * v[j].w); }
            const float r = 1.0f / sqrtf(wave_sum(s) * (1.0f / DM) + 1e-6f);
            f32x4* yo = (f32x4*)(Y + (size_t)m * DM) + lane;
#pragma unroll
            for (int j = 0; j < 8; ++j) { const f32x4 gg = gr[64 * j]; yo[64 * j] = v[j] * r * gg; } } }
}
__device__ __forceinline__ void rms_row_from_bf16(const bf16* xb, const float* g, float* yrow, int lane) {
    const u32x2* xr = (const u32x2*)xb + lane; f32x4 v[8]; float s = 0.f;
#pragma unroll
    for (int j = 0; j < 8; ++j) { const u32x2 w = xr[64 * j]; v[j] = (f32x4){bf_lo(w.x), bf_hi(w.x), bf_lo(w.y), bf_hi(w.y)}; }
#pragma unroll
    for (int j = 0; j < 8; ++j) s += (v[j].x * v[j].x + v[j].y * v[j].y) + (v[j].z * v[j].z + v[j].w * v[j].w);
    const float r = 1.0f / sqrtf(wave_sum(s) * (1.0f / DM) + 1e-6f);
    f32x4* yo = (f32x4*)yrow + lane; const f32x4* gr = (const f32x4*)g + lane;
#pragma unroll
    for (int j = 0; j < 8; ++j) { const f32x4 gg = gr[64 * j]; yo[64 * j] = v[j] * r * gg; }
}
__device__ __forceinline__ void rms_row_f32_inplace(float* xrow, const float* part, int npart, const float* g, int lane) {
    f32x4 v[8]; const float r = 1.0f / sqrtf(load_row_sumsq(v, xrow, xrow, part, npart, lane) * (1.0f / DM) + 1e-6f);
    f32x4* xr = (f32x4*)xrow + lane; const f32x4* gr = (const f32x4*)g + lane;
#pragma unroll
    for (int j = 0; j < 8; ++j) { const f32x4 gg = gr[64 * j]; xr[64 * j] = v[j] * r * gg; }
}

struct KVDesc { const bf16* kb; const bf16* vb; const float* kf; const float* vf; int strideb, stridef, n_f32, n_b16, zero_lo; };
__device__ __forceinline__ int vpos(int key) { return (key & ~31) + (((key & 15) >> 2) << 3) + (key & 3) + (((key >> 4) & 1) << 2); }
template <int D> __device__ __forceinline__ void attn_load_kv(LAS unsigned char* lds, const KVDesc& kv, int tid) {
    constexpr int KSTR = D * 2 + 16, VSTR = 528, CH = D / 8, VT_OFF = 256 * KSTR;
#pragma unroll 1
    for (int idx = tid; idx < 64 * CH; idx += NTHREADS) {
        const int blk = idx >> 6, key0 = ((blk & 3) * 16 + (idx & 15)) * 4, c = (blk >> 2) * 4 + ((idx >> 4) & 3);
        u32x4 kk[4], vv[4];
#pragma unroll
        for (int i = 0; i < 4; ++i) {
            const int key = key0 + i;
            kk[i] = (u32x4){0u, 0u, 0u, 0u}; vv[i] = (u32x4){0u, 0u, 0u, 0u};
            if (key >= kv.zero_lo && key < kv.n_f32 + kv.n_b16) {
                if (key < kv.n_f32) {
                    const f32x4* ks = (const f32x4*)(kv.kf + (size_t)key * kv.stridef + c * 8); const f32x4* vs = (const f32x4*)(kv.vf + (size_t)key * kv.stridef + c * 8);
                    const f32x4 a = ks[0], b = ks[1], e = vs[0], f = vs[1];
                    kk[i].x = pk2(a.x, a.y); kk[i].y = pk2(a.z, a.w); kk[i].z = pk2(b.x, b.y); kk[i].w = pk2(b.z, b.w);
                    vv[i].x = pk2(e.x, e.y); vv[i].y = pk2(e.z, e.w); vv[i].z = pk2(f.x, f.y); vv[i].w = pk2(f.z, f.w);
                } else {
                    kk[i] = *(const u32x4*)(kv.kb + (long)(key - kv.n_f32) * kv.strideb + c * 8); vv[i] = *(const u32x4*)(kv.vb + (long)(key - kv.n_f32) * kv.strideb + c * 8);
                }
            }
        }
#pragma unroll
        for (int i = 0; i < 4; ++i) *(LAS u32x4*)(lds + (key0 + i) * KSTR + c * 16) = kk[i];
        LAS unsigned char* vb = lds + VT_OFF + (c * 8) * VSTR + vpos(key0) * 2;
#pragma unroll
        for (int w = 0; w < 4; ++w) {
            u32x2 lo, hi;
            lo.x = (vv[0][w] & 0xffffu) | (vv[1][w] << 16); lo.y = (vv[2][w] & 0xffffu) | (vv[3][w] << 16);
            hi.x = (vv[0][w] >> 16) | (vv[1][w] & 0xffff0000u); hi.y = (vv[2][w] >> 16) | (vv[3][w] & 0xffff0000u);
            *(LAS u32x2*)(vb + (2 * w) * VSTR) = lo; *(LAS u32x2*)(vb + (2 * w + 1) * VSTR) = hi;
        }
    }
}
template <int D> __device__ __forceinline__ void attn_loadq(bf16x8 (&qf)[D / 32], const bf16* qrow, int lane) {
#pragma unroll
    for (int kk = 0; kk < D / 32; ++kk) qf[kk] = *(const bf16x8*)(qrow + 32 * kk + 8 * (lane >> 4));
}
template <int D, bool BAND> __device__ __forceinline__ void attn16(const LAS unsigned char* lds, const bf16x8 (&qf)[D / 32], bf16* orow, bool row_valid, int qi, bool prev_valid, float sinkl2, int kt_lo, int kt_hi, int lane) {
    constexpr int KSTR = D * 2 + 16, VSTR = 528, NKK = D / 32, NDT = D / 16, VT_OFF = 256 * KSTR;
    const int fr = lane & 15, fq = lane >> 4;
    const float NEGI = -__builtin_inff();
    f32x4 s[16];
#pragma unroll
    for (int kt = 0; kt < 16; ++kt) {
        if (!BAND || (kt >= kt_lo && kt <= kt_hi)) { s[kt] = (f32x4){0.f, 0.f, 0.f, 0.f};
#pragma unroll
            for (int kk = 0; kk < NKK; ++kk) { const bf16x8 kf = *(const LAS bf16x8*)(lds + (16 * kt + fr) * KSTR + (32 * kk + 8 * fq) * 2);
                s[kt] = __builtin_amdgcn_mfma_f32_16x16x32_bf16(kf, qf[kk], s[kt], 0, 0, 0); }
        } else s[kt] = (f32x4){NEGI, NEGI, NEGI, NEGI}; }
    const float cs = (D == 128 ? 0.08838834764831845f : 0.125f) * 1.4426950408889634f;
    const float NEG = -__builtin_inff();
    float mx = NEG;
#pragma unroll
    for (int kt = 0; kt < 16; ++kt)
#pragma unroll
        for (int r = 0; r < 4; ++r) { float v = s[kt][r] * cs;
            if (BAND) { const int kj = 16 * kt + 4 * fq + r; const bool ok = (kj > qi) && (kj <= qi + 128) && (prev_valid || kj >= 128); v = ok ? v : NEG; }
            s[kt][r] = v; mx = fmaxf(mx, v); }
    mx = fmaxf(mx, __shfl_xor(mx, 16)); mx = fmaxf(mx, __shfl_xor(mx, 32));
    if (BAND) mx = fmaxf(mx, sinkl2);
    float sum = 0.f;
#pragma unroll
    for (int kt = 0; kt < 16; ++kt)
#pragma unroll
        for (int r = 0; r < 4; ++r) { const float e = __builtin_amdgcn_exp2f(s[kt][r] - mx); s[kt][r] = e; sum += e; }
    sum += __shfl_xor(sum, 16); sum += __shfl_xor(sum, 32);
    if (BAND) sum += __builtin_amdgcn_exp2f(sinkl2 - mx);
    const float inv = 1.0f / sum;
    f32x4 o[NDT];
#pragma unroll
    for (int dt = 0; dt < NDT; ++dt) o[dt] = (f32x4){0.f, 0.f, 0.f, 0.f};
#pragma unroll
    for (int sl = 0; sl < 8; ++sl) {
        if (BAND && (2 * sl + 1 < kt_lo || 2 * sl > kt_hi)) continue;
        u32x4 pw; pw.x = pk2(s[2 * sl][0], s[2 * sl][1]); pw.y = pk2(s[2 * sl][2], s[2 * sl][3]); pw.z = pk2(s[2 * sl + 1][0], s[2 * sl + 1][1]); pw.w = pk2(s[2 * sl + 1][2], s[2 * sl + 1][3]);
        const bf16x8 pf = __builtin_bit_cast(bf16x8, pw);
#pragma unroll
        for (int dt = 0; dt < NDT; ++dt) { const bf16x8 vf = *(const LAS bf16x8*)(lds + VT_OFF + (16 * dt + fr) * VSTR + (32 * sl + 8 * fq) * 2);
            o[dt] = __builtin_amdgcn_mfma_f32_16x16x32_bf16(vf, pf, o[dt], 0, 0, 0); } }
    if (row_valid) {
#pragma unroll
        for (int dt = 0; dt < NDT; ++dt) { u32x2 w; w.x = pk2(o[dt][0] * inv, o[dt][1] * inv); w.y = pk2(o[dt][2] * inv, o[dt][3] * inv); *(u32x2*)(orow + 16 * dt + 4 * fq) = w; }
    }
}

__global__ void __launch_bounds__(NTHREADS, 2) fwd_megakernel(Params p) {
    extern __shared__ __attribute__((aligned(16))) unsigned char lds_raw[];
    LAS unsigned char* lds = (LAS unsigned char*)lds_raw;
    cg::grid_group grid = cg::this_grid();
    const int G = gridDim.x, bx = blockIdx.x, NGW = G * NWAVES;
#define PHASE_IDS() const int tid = otid(), lane = tid & 63, wave = __builtin_amdgcn_readfirstlane(tid >> 6), gw = bx * NWAVES + wave; (void)lane; (void)gw
    unsigned char* ws = p.ws;
    float* out = p.out;
    bf16* WIN0 = (bf16*)(ws + WS_WIN0); bf16* WMEM = (bf16*)(ws + WS_WMEM); bf16* WIN1 = (bf16*)(ws + WS_WIN1); bf16* WOUT = (bf16*)(ws + WS_WOUT);
    bf16* WGU = (bf16*)(ws + WS_WGU); bf16* WDN = (bf16*)(ws + WS_WDN); bf16* H = (bf16*)(ws + WS_H); bf16* MEMH = (bf16*)(ws + WS_MEMH);
    bf16* MIX = (bf16*)(ws + WS_MIX); bf16* ZA = (bf16*)(ws + WS_ZA); bf16* MKV = (bf16*)(ws + WS_MKV);
    float* X = out;
    float* PART = (float*)(ws + WS_PART);
    float* RSP = (float*)(ws + WS_RSP);
    float* RS = (float*)(ws + WS_RS);
    constexpr int SNT_OUT = 4, NSL_OUT = (DM / 64) / SNT_OUT, SNT_DN = 8, NSL_DN = (FF / 64) / SNT_DN;
    unsigned* barw = (unsigned*)(ws + WS_BAR);
    volatile LAS unsigned* MISC = (volatile LAS unsigned*)(lds + MISC_OFF);
    { const int t0 = otid(); if (bx == 0) for (int i = t0; i < XCD_BAR_WORDS; i += NTHREADS) barw[i] = 0u; if (t0 < 2) MISC[t0] = 0u; }
    __syncthreads();

    constexpr int I_IN0 = (DM / 64) * (NIN0 / 32), I_MEM = (DM / 64) * (1024 / 32), I_IN1 = (DM / 64) * (NIN1 / 32), I_OUT = (DM / 64) * (DM / 32), I_GU = (DM / 64) * (FF / 32), I_DN = (FF / 64) * (DM / 32);
    constexpr int NP0 = I_IN0 + 2 * I_MEM + I_IN1 + I_OUT + 2 * I_GU + I_DN, NITEMS = NP0 + I_OUT + 2 * I_GU + I_DN;
#ifndef DQ_
#define DQ_ 5
#endif
    constexpr int DQ = DQ_, DEF_A = 76 * 8 * DQ, DEF_B = 84 * 8 * DQ, DEF_C = 182 * 8 * DQ;
    constexpr int DEF0 = (NITEMS - DEF_A - DEF_B - DEF_C) > NP0 ? (NITEMS - DEF_A - DEF_B - DEF_C) : NP0;
    const bool defer = (G == 256);
#define GET_ITEM(it_, T) do { int r = (it_); int mode = 0; (T).gk = nullptr; (T).K = DM; \
            if (r < I_IN0) { (T).W = p.in[I_CWIN]; (T).WT = WIN0; (T).N = NIN0; } \
            else if ((r -= I_IN0) < I_MEM) { (T).W = p.in[I_WMEMKV]; (T).WT = WMEM; (T).N = 1024; } \
            else if ((r -= I_MEM) < I_MEM) { (T).W = p.in[I_WMEMKV] + (size_t)DM * 1024; (T).WT = WMEM + (size_t)1024 * DM; (T).N = 1024; } \
            else if ((r -= I_MEM) < I_IN1) { (T).W = p.in[I_AWIN]; (T).WT = WIN1; (T).N = NIN1; (T).gk = p.in[I_NMIX] + DM; } \
            else if ((r -= I_IN1) < I_OUT) { (T).W = p.in[I_CWOUT]; (T).WT = WOUT; (T).N = DM; } \
            else if ((r -= I_OUT) < I_GU) { (T).W = p.in[I_WGATE]; (T).WT = WGU; (T).N = FF; mode = 1; (T).gk = p.in[I_NFFN]; } \
            else if ((r -= I_GU) < I_GU) { (T).W = p.in[I_WUP]; (T).WT = WGU; (T).N = FF; mode = 2; (T).gk = p.in[I_NFFN]; } \
            else if ((r -= I_GU) < I_DN) { (T).W = p.in[I_WDOWN]; (T).WT = WDN; (T).N = DM; (T).K = FF; } \
            else if ((r -= I_DN) < I_OUT) { (T).W = p.in[I_AWOUT]; (T).WT = WOUT + (size_t)DM * DM; (T).N = DM; } \
            else if ((r -= I_OUT) < I_GU) { (T).W = p.in[I_WGATE] + (size_t)DM * FF; (T).WT = WGU + (size_t)NGU * DM; (T).N = FF; mode = 1; (T).gk = p.in[I_NFFN] + DM; } \
            else if ((r -= I_GU) < I_GU) { (T).W = p.in[I_WUP] + (size_t)DM * FF; (T).WT = WGU + (size_t)NGU * DM; (T).N = FF; mode = 2; (T).gk = p.in[I_NFFN] + DM; } \
            else { r -= I_GU; (T).W = p.in[I_WDOWN] + (size_t)FF * DM; (T).WT = WDN + (size_t)DM * FF; (T).N = DM; (T).K = FF; } \
            const int nblk = (T).N / 32, kb = r / nblk, nb = r % nblk; (T).n0 = 32 * nb; (T).k0 = 64 * kb; \
            (T).d0 = mode == 0 ? (T).n0 : (256 * ((T).n0 >> 7) + ((T).n0 & 127) + (mode == 2 ? 128 : 0)); } while (0)
#define LOCAL_PTRS() const Params* pp_ = (const Params*)__builtin_amdgcn_kernarg_segment_ptr(); asm volatile("" : "+s"(pp_)); const Params& p = *pp_; unsigned char* ws = p.ws; \
        bf16* WIN0 = (bf16*)(ws + WS_WIN0); bf16* WMEM = (bf16*)(ws + WS_WMEM); bf16* WIN1 = (bf16*)(ws + WS_WIN1); bf16* WOUT = (bf16*)(ws + WS_WOUT); bf16* WGU = (bf16*)(ws + WS_WGU); bf16* WDN = (bf16*)(ws + WS_WDN); \
        (void)WIN0; (void)WMEM; (void)WIN1; (void)WOUT; (void)WGU; (void)WDN
#define CONVERT_SIMPLE(first_, stride_, count_, end_) do { LAS float* scr_ = (LAS float*)(lds + wave * 16384); \
            for (int j_ = 0, it = (first_); j_ < (count_) && it < (end_); ++j_, it += (stride_)) { TItem cur; float wv[32]; GET_ITEM(it, cur); titem_load(cur, wv, lane); titem_store(cur, wv, scr_, lane); } } while (0)
#define CONVERT_ITEMS(first_, stride_, count_, end_) do { LAS float* scr_ = (LAS float*)(lds + wave * 16384); \
            TItem cur, nxt; float wv[32], wn[32]; int it = (first_), left = (count_); const int stride = (stride_), end = (end_); \
            if (it < end && left > 0) { GET_ITEM(it, cur); titem_load(cur, wv, lane); } \
            while (it < end && left > 0) { \
                const int itn = it + stride; const bool hn = itn < end && left > 1; \
                if (hn) { GET_ITEM(itn, nxt); titem_load(nxt, wn, lane); } \
                titem_store(cur, wv, scr_, lane); \
                if (hn) { cur = nxt; titem_copy(wv, wn); } \
                it = itn; --left; } } while (0)
    {
        PHASE_IDS();
        CONVERT_ITEMS(gw, NGW, (1 << 30), defer ? DEF0 : NITEMS);

        for (int i = bx * NTHREADS + tid; i < NSR * DM / 4; i += G * NTHREADS) ((f32x4*)(X + (size_t)NPR * DM))[i] = ((const f32x4*)p.in[I_XS])[i];
        for (int i = bx * NTHREADS + tid; i < 4 * MT; i += G * NTHREADS) RS[i] = 0.f;
        for (int m = gw; m < 2048; m += NGW) { const int li = m >> 10, r = m & 1023; rms_row_bf16(p.in[I_MEMP] + (size_t)r * DM, nullptr, nullptr, 0, p.in[I_NMEM] + li * DM, MEMH + (size_t)m * DM, lane); }
        for (int m = gw; m < MT; m += NGW) { const float* xr = m < NPR ? p.in[I_XP] + (size_t)m * DM : p.in[I_XS] + (size_t)(m - NPR) * DM; rms_row_bf16(xr, nullptr, nullptr, 0, p.in[I_NMIX], H + (size_t)m * DM, lane); }
    }
    grid.sync();
    const XcdBarrier xbar = xcd_barrier_post(barw, MISC);

#pragma unroll 1
    for (int li = 0; li < 2; ++li) {
        const int NIN = li ? NIN1 : NIN0;
        const int QMOFF = li ? 2048 : 4608;
        bf16* Z = ZA;
        if (li == 0) {
            pg8::Gemm g{MEMH, WMEM, 2048, 2048, DM}; pg8::MemOrder S{G, (bx + G - (200 % G)) % G};
            pg8::EpiMem E{out + OUT_MK, out + OUT_MV, MKV};
            pg8::gemm_phase<pg8::EpiMem, pg8::MemOrder, true, true>(lds, g, S, E);
        }

        {
            pg8::Gemm g{H, li ? WIN1 : WIN0, MT, NIN, DM}; pg8::StaticOrder S; S.init(MT, NIN, G, bx, DM);
            pg8::EpiZ E{Z, NIN, li ? RS + MT : nullptr};
            pg8::gemm_phase<pg8::EpiZ, pg8::StaticOrder, true, true>(lds, g, S, E);
        }
        if (defer) {
            PHASE_IDS();
            if (li == 0) { const int r = (bx >= 148 && bx < 200) ? bx - 148 : (bx >= 232 ? 52 + bx - 232 : -1);
                if (r >= 0) CONVERT_SIMPLE(DEF0 + r * 8 + wave, 76 * 8, DQ, DEF0 + DEF_A); }
            else if (bx >= 74) CONVERT_SIMPLE(DEF0 + DEF_A + DEF_B + (bx - 74) * 8 + wave, 182 * 8, DQ, NITEMS);
        }

        xcd_barrier(xbar);
        {
            PHASE_IDS();
            for (int u = bx; u < 256; u += G) {
                KVDesc kv; int row0, h, niter; bool valid;
                if (u < 128) { const int b = u >> 5; h = (u >> 3) & 3; const int ch = u & 7;
                    kv.kb = MKV + (size_t)li * 1048576 + (size_t)(b * 256) * 1024 + h * 128; kv.vb = kv.kb + 512; kv.kf = nullptr; kv.vf = nullptr; kv.strideb = 1024; kv.stridef = 0; kv.n_f32 = 0; kv.n_b16 = 256; kv.zero_lo = 0;
                    row0 = b * 2048 + ch * 256 + wave * 32 + (lane & 15); valid = true; niter = 2;
                } else { const int s = u - 128, b = s >> 2; h = s & 3;
                    kv.kf = p.in[I_CMK] + (size_t)((li * 32 + b) * 256) * 512 + h * 128; kv.vf = p.in[I_CMV] + (size_t)((li * 32 + b) * 256) * 512 + h * 128; kv.kb = nullptr; kv.vb = nullptr; kv.strideb = 0; kv.stridef = 512; kv.n_f32 = 256; kv.n_b16 = 0; kv.zero_lo = 0;
                    row0 = NPR + b * 8 + (lane & 7); valid = (lane & 15) < 8; niter = (wave == 0) ? 1 : 0;
                }
                attn_load_kv<128>(lds, kv, tid);
                __syncthreads();
                for (int t = 0; t < niter; ++t) {
                    asm volatile("" ::: "memory");
                    const int row = row0 + 16 * t;
                    bf16x8 qf[4]; attn_loadq<128>(qf, Z + (size_t)row * NIN + QMOFF + h * 128, lane);
                    attn16<128, false>(lds, qf, MIX + (size_t)row * DM + TW + h * 128, valid, 0, true, 0.f, 0, 15, lane);
                }
                __syncthreads();
            }

            if (li == 0) {
                const float* cw = p.in[I_CW];
                for (int item = bx * NTHREADS + tid; item < 1056 * 192; item += G * NTHREADS) {
                    const int run = item / 192, ch0 = (item % 192) * 8;
                    float w0[8], w1[8], w2[8], pm2[8], pm1[8];
#pragma unroll
                    for (int i = 0; i < 8; ++i) { w0[i] = cw[ch0 + i]; w1[i] = cw[TW + ch0 + i]; w2[i] = cw[2 * TW + ch0 + i]; pm2[i] = 0.f; pm1[i] = 0.f; }
                    int row0; bool last; float* so;
                    if (run < 1024) { const int b = run >> 8, t0 = (run & 255) * 8; row0 = b * 2048 + t0; last = (run & 255) == 255; so = out + OUT_CP + (size_t)(b * 2) * TW + ch0;
                        if (t0 > 0) {
                            const bf16* z2 = Z + (size_t)(row0 - 2) * NIN0 + ch0; const bf16* z1 = z2 + NIN0;
                            const u32x4 c2 = *(const u32x4*)(z2 + TW), u2 = *(const u32x4*)(z2 + 2 * TW), c1 = *(const u32x4*)(z1 + TW), u1 = *(const u32x4*)(z1 + 2 * TW);
#pragma unroll
                            for (int i = 0; i < 4; ++i) { pm2[2 * i] = bf_lo(c2[i]) * bf_lo(u2[i]); pm2[2 * i + 1] = bf_hi(c2[i]) * bf_hi(u2[i]); pm1[2 * i] = bf_lo(c1[i]) * bf_lo(u1[i]); pm1[2 * i + 1] = bf_hi(c1[i]) * bf_hi(u1[i]); }
                        }
                    } else { const int b = run - 1024; row0 = NPR + b * 8; last = true; so = out + OUT_CS + (size_t)(b * 2) * TW + ch0;
                        const float* sc = p.in[I_SCONV] + (size_t)(b * 2) * TW + ch0;
#pragma unroll
                        for (int i = 0; i < 8; ++i) { pm2[i] = sc[i]; pm1[i] = sc[TW + i]; }
                    }
#pragma unroll
                    for (int t = 0; t < 8; ++t) {
                        const bf16* zr = Z + (size_t)(row0 + t) * NIN0 + ch0;
                        const u32x4 bb = *(const u32x4*)zr, cc = *(const u32x4*)(zr + TW), uu = *(const u32x4*)(zr + 2 * TW);
                        float tok[8];
#pragma unroll
                        for (int i = 0; i < 4; ++i) {
                            const float cu0 = bf_lo(cc[i]) * bf_lo(uu[i]), cu1 = bf_hi(cc[i]) * bf_hi(uu[i]);
                            tok[2 * i] = bf_lo(bb[i]) * (w0[2 * i] * pm2[2 * i] + w1[2 * i] * pm1[2 * i] + w2[2 * i] * cu0);
                            tok[2 * i + 1] = bf_hi(bb[i]) * (w0[2 * i + 1] * pm2[2 * i + 1] + w1[2 * i + 1] * pm1[2 * i + 1] + w2[2 * i + 1] * cu1);
                            pm2[2 * i] = pm1[2 * i]; pm2[2 * i + 1] = pm1[2 * i + 1]; pm1[2 * i] = cu0; pm1[2 * i + 1] = cu1;
                        }
                        u32x4 w; w.x = pk2(tok[0], tok[1]); w.y = pk2(tok[2], tok[3]); w.z = pk2(tok[4], tok[5]); w.w = pk2(tok[6], tok[7]);
                        *(u32x4*)(MIX + (size_t)(row0 + t) * DM + ch0) = w;
                    }
                    if (last) {
#pragma unroll
                        for (int i = 0; i < 8; ++i) { so[i] = pm2[i]; so[TW + i] = pm1[i]; }
                    }
                }

            } else {
                const float* sinks = p.in[I_SINKS];
                for (int u = bx; u < 384; u += G) {
                    KVDesc kv; int b, kh, blk = 0; const bool isp = u < 256;
                    if (isp) { b = u >> 6; blk = (u >> 2) & 15; kh = u & 3;
                        kv.kb = Z + ((long)(b * 2048 + (blk - 1) * 128)) * NIN1 + TW + 64 * kh; kv.vb = kv.kb + 256; kv.kf = nullptr; kv.vf = nullptr; kv.strideb = NIN1; kv.stridef = 0; kv.n_f32 = 0; kv.n_b16 = 256; kv.zero_lo = blk == 0 ? 128 : 0;
                    } else { const int s = u - 256; b = s >> 2; kh = s & 3;
                        kv.kf = p.in[I_CWK] + (size_t)(b * 128) * 256 + kh * 64; kv.vf = p.in[I_CWV] + (size_t)(b * 128) * 256 + kh * 64; kv.stridef = 256; kv.n_f32 = 128;
                        kv.kb = Z + (size_t)(NPR + b * 8) * NIN1 + TW + 64 * kh; kv.vb = kv.kb + 256; kv.strideb = NIN1; kv.n_b16 = 8; kv.zero_lo = 0;
                    }
                    attn_load_kv<64>(lds, kv, tid);
                    __syncthreads();
                    const int niter = isp ? 6 : (wave < 3 ? 1 : 0);
                    const int qi = isp ? wave * 16 + (lane & 15) : (lane & 7);
                    const int row = isp ? b * 2048 + blk * 128 + qi : NPR + b * 8 + qi;
                    const int hq0 = isp ? 6 * kh : 6 * kh + 2 * wave + ((lane & 15) >> 3);
                    const int kt_lo = isp ? (blk == 0 && wave < 8 ? 8 : wave) : 0, kt_hi = isp ? wave + 8 : 8;
                    for (int it = 0; it < niter; ++it) {
                        asm volatile("" ::: "memory");
                        const int hq = hq0 + it;
                        bf16x8 qc[2]; attn_loadq<64>(qc, Z + (size_t)row * NIN1 + hq * 64, lane);
                        attn16<64, true>(lds, qc, MIX + (size_t)row * DM + hq * 64, true, qi, !isp || blk > 0, sinks[hq] * 1.4426950408889634f, kt_lo, kt_hi, lane);
                    }
                    __syncthreads();
                }

                for (int e = bx * NTHREADS + tid; e < 4 * 128 * 128; e += G * NTHREADS) {
                    const int c = (e & 127) * 4, j = (e >> 7) & 127, b = e >> 14;
                    const u32x2 v = *(const u32x2*)(Z + (size_t)(b * 2048 + 1920 + j) * NIN1 + TW + c);
                    *(f32x4*)(out + (c < 256 ? OUT_WKP : OUT_WVP) + (size_t)(b * 128 + j) * 256 + (c & 255)) = (f32x4){bf_lo(v.x), bf_hi(v.x), bf_lo(v.y), bf_hi(v.y)};
                }
#pragma unroll 4
                for (int e = bx * NTHREADS + tid; e < 32 * 128 * 128; e += G * NTHREADS) {
                    const int c = (e & 127) * 4, j = (e >> 7) & 127, b = e >> 14; f32x4 v;
                    if (j < 120) v = *(const f32x4*)((c < 256 ? p.in[I_CWK] : p.in[I_CWV]) + (size_t)(b * 128 + 8 + j) * 256 + (c & 255));
                    else { const u32x2 w = *(const u32x2*)(Z + (size_t)(NPR + b * 8 + j - 120) * NIN1 + TW + c); v = (f32x4){bf_lo(w.x), bf_hi(w.x), bf_lo(w.y), bf_hi(w.y)}; }
                    *(f32x4*)(out + (c < 256 ? OUT_WKS : OUT_WVS) + (size_t)(b * 128 + j) * 256 + (c & 255)) = v;
                }
            }
        }
        xcd_barrier(xbar);
        {
            pg8::Gemm g{MIX, WOUT + (size_t)li * DM * DM, MT, DM, DM}; pg8::TailOrder S; S.init(G, bx, DM, SNT_OUT);
            pg8::EpiResid E{li ? nullptr : p.in[I_XP], nullptr, PART, H, RSP, true};
            pg8::gemm_phase<pg8::EpiResid, pg8::TailOrder, true, true>(lds, g, S, E);
        }

        xcd_barrier(xbar);
        { PHASE_IDS(); fixup_phase(X, PART, NSL_OUT, H, RS + (size_t)(2 * li) * MT, RSP, (LAS float*)lds, bx, G, tid); }
        xcd_barrier(xbar);
        {
            pg8::Gemm g{H, WGU + (size_t)li * NGU * DM, MT, NGU, DM}; pg8::StaticOrder S; S.init(MT, NGU, G, bx, DM);
            pg8::EpiSwiglu E{ZA, RS + (size_t)(2 * li) * MT};
            pg8::gemm_phase<pg8::EpiSwiglu, pg8::StaticOrder, true, true>(lds, g, S, E);
        }
        if (defer && li == 0 && bx >= 172) { PHASE_IDS(); CONVERT_SIMPLE(DEF0 + DEF_A + (bx - 172) * 8 + wave, 84 * 8, DQ, DEF0 + DEF_A + DEF_B); }

        xcd_barrier(xbar);
        {
            pg8::Gemm g{ZA, WDN + (size_t)li * DM * FF, MT, DM, FF}; pg8::TailOrder S; S.init(G, bx, FF, SNT_DN);
            pg8::EpiResid E{nullptr, nullptr, PART, H, RSP, true};
            pg8::gemm_phase<pg8::EpiResid, pg8::TailOrder, true, true>(lds, g, S, E);
        }

        xcd_barrier(xbar);
        if (li == 0) {
            { PHASE_IDS(); fixup_phase(X, PART, NSL_DN, H, RS + (size_t)MT, RSP, (LAS float*)lds, bx, G, tid); }
            xcd_barrier(xbar);
        }
    }
    { PHASE_IDS(); final_sample_rows(X, PART, NSL_DN, p.in[I_NFINAL], (LAS float*)lds, bx, G, tid); for (int m = gw; m < NPR; m += 4 * NGW) rms_rows_from_bf16<4>(H, m, NGW, NPR, p.in[I_NFINAL], X, lane); }
}

extern "C" void kernel_launch(void* const* d_in, const int* in_sizes, int n_in, void* d_out, int out_size, void* d_ws, size_t ws_size, hipStream_t stream) {
    static int grid = 0;
    if (grid == 0) {
        if (n_in != 22 || (size_t)out_size != OUT_END || ws_size < WS_END) { fprintf(stderr, "kernel_launch: unexpected shapes (n_in %d out %d ws %zu)\n", n_in, out_size, ws_size); grid = -1; return; }
        int dev = 0, cus = 0, per_cu = 0;
        if (hipGetDevice(&dev) != hipSuccess || hipDeviceGetAttribute(&cus, hipDeviceAttributeMultiprocessorCount, dev) != hipSuccess) { grid = -1; return; }
        if (hipFuncSetAttribute((const void*)fwd_megakernel, hipFuncAttributeMaxDynamicSharedMemorySize, LDS_BYTES) != hipSuccess) { fprintf(stderr, "kernel_launch: hipFuncSetAttribute failed\n"); grid = -1; return; }
        if (hipOccupancyMaxActiveBlocksPerMultiprocessor(&per_cu, (const void*)fwd_megakernel, NTHREADS, LDS_BYTES) != hipSuccess || per_cu < 1) { fprintf(stderr, "kernel_launch: occupancy query says %d\n", per_cu); per_cu = 1; }
        (void)hipGetLastError();
        grid = cus * 1;
    }
    if (grid < 0) return;
    Params prm{};
    for (int i = 0; i < 22; ++i) prm.in[i] = (const float*)d_in[i];
    prm.out = (float*)d_out; prm.ws = (unsigned char*)d_ws;
    void* args[] = {&prm};
    hipError_t e = hipLaunchCooperativeKernel((const void*)fwd_megakernel, dim3(grid), dim3(NTHREADS), args, LDS_BYTES, stream);
    if (e != hipSuccess) fprintf(stderr, "kernel_launch: cooperative launch failed: %s (grid %d)\n", hipGetErrorString(e), grid);
}
```

```cpp
#include <hip/hip_runtime.h>
#include <hip/hip_cooperative_groups.h>
#include <cstdio>
#include <cstdint>
namespace cg = cooperative_groups;
namespace pg8 {
#define PG8_LAS __attribute__((address_space(3)))
typedef unsigned short bf16_t;
typedef short bf16x8 __attribute__((ext_vector_type(8)));
typedef float f32x4 __attribute__((ext_vector_type(4)));
typedef unsigned u32x4 __attribute__((ext_vector_type(4)));
typedef unsigned u32x2 __attribute__((ext_vector_type(2)));
constexpr int BM = 256, BK = 64, HALF = 128, HTB = HALF * BK * 2  , STAGE_BYTES = 8 * HTB, NXCD = 8, WGM = 8;

__host__ __device__ __forceinline__ int lds_byte(int r, int c) { const int st = (r >> 4) * 2 + (c >> 5), rr = r & 15, cc = c & 31, ob = rr * 64 + cc * 2; return st * 1024 + (ob ^ (((ob >> 9) & 1) << 5)); }
__host__ __device__ __forceinline__ void stage_rc(int b, int& R, int& C) { const int st = b / 1024, sb = b % 1024, swz = sb ^ (((sb >> 9) & 1) << 5); R = (st >> 1) * 16 + swz / 64; C = (st & 1) * 32 + (swz % 64) / 2; }
__host__ __device__ __forceinline__ int perm32(int rho) { const int n = rho >> 4, i = rho & 15; return 8 * (i >> 2) + 4 * n + (i & 3); }

struct Unit { int pm, pn, k0, nt; };
struct Gemm { const bf16_t* A; const bf16_t* Bt; int M, N, K; };

struct StaticOrder {
    int nM, nN, nwg, G, c, ntf;
    __host__ __device__ void init(int M, int N, int G_, int c_, int K) { nM = M / BM; nN = N / BM; nwg = nM * nN; G = G_; c = c_; ntf = K / BK; }
    __host__ __device__ bool next(int i, Unit& u) const {
        const long L = (long)i * G + c; if (L >= nwg) return false;
        int wgid = (int)L; { const int q = nwg / NXCD, r = nwg % NXCD, xcd = wgid % NXCD, off = wgid / NXCD; wgid = (xcd < r ? xcd * (q + 1) : r * (q + 1) + (xcd - r) * q) + off; }
        const int nig = WGM * nN, gid = wgid / nig, fm = gid * WGM, gsz = (nM - fm) < WGM ? (nM - fm) : WGM;
        u.pm = fm + ((wgid % nig) % gsz); u.pn = (wgid % nig) / gsz; u.k0 = 0; u.nt = ntf; return true;
    }
    __device__ __forceinline__ void a_ready(const Unit&) const {}
    __device__ __forceinline__ void done(const Unit&) const {}
};

__device__ __forceinline__ unsigned cvt_pk_bf16(float lo, float hi) { unsigned r; asm volatile("v_cvt_pk_bf16_f32 %0, %1, %2" : "=v"(r) : "v"(lo), "v"(hi)); return r; }

struct MemOrder {
    int G, c;
    __device__ bool next(int i, Unit& u) const { const int L = i * G + c; if (L >= 32) return false; const int li = L >> 4, r = L & 15; u.pm = li * 4 + (r >> 2); u.pn = li * 4 + (r & 3); u.k0 = 0; u.nt = 32; return true; }
    __device__ __forceinline__ void a_ready(const Unit&) const {}
    __device__ __forceinline__ void done(const Unit&) const {}
};

struct TailOrder {
    StaticOrder main; int G, c, snt, nsub;
    __device__ void init(int G_, int c_, int K, int snt_) { main.init(8192, 2048, G_, c_, K); G = G_; c = c_; snt = snt_; nsub = 8 * ((K / BK) / snt_); }
    __device__ bool next(int i, Unit& u) const {
        const int nm = c < 256 ? (256 - c + G - 1) / G : 0;
        if (i < nm) return main.next(i, u);
        const int Ls = (i - nm) * G + c; if (Ls >= nsub) return false;
        u.pm = 32; u.pn = Ls & 7; u.k0 = (Ls >> 3) * snt; u.nt = snt; return true;
    }
    __device__ __forceinline__ void a_ready(const Unit&) const {}
    __device__ __forceinline__ void done(const Unit&) const {}
};

struct EpiZ {
    static constexpr bool PERM = true, AFTER_DRAIN = false;
    __device__ __forceinline__ void init(f32x4 (&)[2][2][4][2], const Unit&, int, int, int, int) const {}
    bf16_t* O; int ldc; const float* RS;
    __device__ __forceinline__ void operator()(const f32x4 (&acc)[2][2][4][2], const Unit& u, int wr, int wc, int fr, int fq) const {
        const int row0 = u.pm * BM + wr * 64 + fr, col0 = u.pn * BM + wc * 32 + 8 * fq;
        float scv[2][4];
#pragma unroll
        for (int ai = 0; ai < 2; ++ai)
#pragma unroll
            for (int m = 0; m < 4; ++m) scv[ai][m] = RS ? RS[row0 + ai * HALF + m * 16] : 0.f;
#pragma unroll
        for (int ai = 0; ai < 2; ++ai)
#pragma unroll
            for (int m = 0; m < 4; ++m) scv[ai][m] = RS ? __builtin_amdgcn_rsqf(scv[ai][m] * (1.0f / 2048.0f) + 1e-6f) : 1.0f;
        asm volatile("" ::: "memory");
#pragma unroll
        for (int ai = 0; ai < 2; ++ai)
#pragma unroll
            for (int m = 0; m < 4; ++m) { bf16_t* rowp = O + (size_t)(row0 + ai * HALF + m * 16) * ldc + col0;
                const float sc = scv[ai][m];
#pragma unroll
                for (int bj = 0; bj < 2; ++bj) { const f32x4 v0 = acc[ai][bj][m][0] * sc, v1 = acc[ai][bj][m][1] * sc;
                    u32x4 w; w.x = cvt_pk_bf16(v0[0], v0[1]); w.y = cvt_pk_bf16(v0[2], v0[3]); w.z = cvt_pk_bf16(v1[0], v1[1]); w.w = cvt_pk_bf16(v1[2], v1[3]);
                    *(u32x4*)(rowp + bj * HALF) = w; } }
    }
};
struct EpiMem {
    static constexpr bool PERM = true, AFTER_DRAIN = false;
    __device__ __forceinline__ void init(f32x4 (&)[2][2][4][2], const Unit&, int, int, int, int) const {}
    float* outK; float* outV; bf16_t* MKV;
    __device__ __forceinline__ void operator()(const f32x4 (&acc)[2][2][4][2], const Unit& u, int wr, int wc, int fr, int fq) const {
        const int li = u.pm >> 2, row0 = (u.pm & 3) * BM + wr * 64 + fr, ct = (u.pn & 3) * BM, isv = ct >= 512;
        const int col0 = ct + wc * 32 + 8 * fq;
        float* ob = (isv ? outV : outK) + (size_t)li * (1024 * 512) + (col0 - (isv ? 512 : 0));
        bf16_t* bb = MKV + (size_t)li * (1024 * 1024) + col0;
#pragma unroll
        for (int ai = 0; ai < 2; ++ai)
#pragma unroll
            for (int m = 0; m < 4; ++m) { const int row = row0 + ai * HALF + m * 16;
#pragma unroll
                for (int bj = 0; bj < 2; ++bj) { const f32x4 v0 = acc[ai][bj][m][0], v1 = acc[ai][bj][m][1];
                    *(f32x4*)(ob + (size_t)row * 512 + bj * HALF) = v0; *(f32x4*)(ob + (size_t)row * 512 + bj * HALF + 4) = v1;
                    u32x4 w; w.x = cvt_pk_bf16(v0[0], v0[1]); w.y = cvt_pk_bf16(v0[2], v0[3]); w.z = cvt_pk_bf16(v1[0], v1[1]); w.w = cvt_pk_bf16(v1[2], v1[3]);
                    *(u32x4*)(bb + (size_t)row * 1024 + bj * HALF) = w; } }
    }
};
struct EpiResid {
    static constexpr bool PERM = true, AFTER_DRAIN = false;
    __device__ __forceinline__ void init(f32x4 (&acc)[2][2][4][2], const Unit& u, int wr, int wc, int fr, int fq) const {
        if (u.pm == 32) return;
        const int row0 = u.pm * BM + wr * 64 + fr, col0 = u.pn * BM + wc * 32 + 8 * fq;
#pragma unroll
        for (int ai = 0; ai < 2; ++ai)
#pragma unroll
            for (int m = 0; m < 4; ++m) { const size_t off = (size_t)(row0 + ai * HALF + m * 16) * 2048 + col0;
#pragma unroll
                for (int bj = 0; bj < 2; ++bj) {
                    if (baseP) { acc[ai][bj][m][0] = *(const f32x4*)(baseP + off + bj * HALF); acc[ai][bj][m][1] = *(const f32x4*)(baseP + off + bj * HALF + 4); }
                    else { const u32x4 w = *(const u32x4*)(XB + off + bj * HALF);
                        acc[ai][bj][m][0] = (f32x4){__builtin_bit_cast(float, w.x << 16), __builtin_bit_cast(float, w.x & 0xffff0000u), __builtin_bit_cast(float, w.y << 16), __builtin_bit_cast(float, w.y & 0xffff0000u)};
                        acc[ai][bj][m][1] = (f32x4){__builtin_bit_cast(float, w.z << 16), __builtin_bit_cast(float, w.z & 0xffff0000u), __builtin_bit_cast(float, w.w << 16), __builtin_bit_cast(float, w.w & 0xffff0000u)}; } } }
#pragma unroll
        for (int ai = 0; ai < 2; ++ai)
#pragma unroll
            for (int m = 0; m < 4; ++m)
                asm volatile("" : "+v"(acc[ai][0][m][0]), "+v"(acc[ai][0][m][1]), "+v"(acc[ai][1][m][0]), "+v"(acc[ai][1][m][1]));
    }
    const float* baseP; float* X; float* P; bf16_t* XB; float* RS; bool wb;
    __device__ __forceinline__ void operator()(const f32x4 (&acc)[2][2][4][2], const Unit& u, int wr, int wc, int fr, int fq) const {
        const int row0 = u.pm * BM + wr * 64 + fr, col0 = u.pn * BM + wc * 32 + 8 * fq;
        if (u.pm == 32) {
            bf16_t* pb = (bf16_t*)P + (size_t)(u.k0 / u.nt) * (256 * 2048) - (size_t)8192 * 2048;
#pragma unroll
            for (int ai = 0; ai < 2; ++ai)
#pragma unroll
                for (int m = 0; m < 4; ++m) { const size_t off = (size_t)(row0 + ai * HALF + m * 16) * 2048 + col0;
#pragma unroll
                    for (int bj = 0; bj < 2; ++bj) { const f32x4 x0 = acc[ai][bj][m][0], x1 = acc[ai][bj][m][1];
                        u32x4 w; w.x = cvt_pk_bf16(x0[0], x0[1]); w.y = cvt_pk_bf16(x0[2], x0[3]); w.z = cvt_pk_bf16(x1[0], x1[1]); w.w = cvt_pk_bf16(x1[2], x1[3]); *(u32x4*)(pb + off + bj * HALF) = w; } }
            return;
        }
#pragma unroll
        for (int ai = 0; ai < 2; ++ai)
#pragma unroll
            for (int m = 0; m < 4; ++m) { const size_t off = (size_t)(row0 + ai * HALF + m * 16) * 2048 + col0; float ss = 0.f;
#pragma unroll
                for (int bj = 0; bj < 2; ++bj) { const f32x4 x0 = acc[ai][bj][m][0], x1 = acc[ai][bj][m][1];
                    if (X) { *(f32x4*)(X + off + bj * HALF) = x0; *(f32x4*)(X + off + bj * HALF + 4) = x1; }
                    ss += ((x0[0] * x0[0] + x0[1] * x0[1]) + (x0[2] * x0[2] + x0[3] * x0[3])) + ((x1[0] * x1[0] + x1[1] * x1[1]) + (x1[2] * x1[2] + x1[3] * x1[3]));
                    if (wb) { u32x4 w; w.x = cvt_pk_bf16(x0[0], x0[1]); w.y = cvt_pk_bf16(x0[2], x0[3]); w.z = cvt_pk_bf16(x1[0], x1[1]); w.w = cvt_pk_bf16(x1[2], x1[3]); *(u32x4*)(XB + off + bj * HALF) = w; } }
                ss += __shfl_xor(ss, 16); ss += __shfl_xor(ss, 32);
                if (fq == 0) RS[(size_t)(u.pn * 4 + wc) * 8448 + row0 + ai * HALF + m * 16] = ss;
                asm volatile("" ::: "memory"); }
    }
};
struct EpiSwiglu {
    static constexpr bool PERM = true, AFTER_DRAIN = false;
    __device__ __forceinline__ void init(f32x4 (&)[2][2][4][2], const Unit&, int, int, int, int) const {}
    bf16_t* O; const float* RS;
    __device__ __forceinline__ void operator()(const f32x4 (&acc)[2][2][4][2], const Unit& u, int wr, int wc, int fr, int fq) const {
        const int row0 = u.pm * BM + wr * 64 + fr, col0 = u.pn * HALF + wc * 32 + 8 * fq;
        float scv[2][4];
#pragma unroll
        for (int ai = 0; ai < 2; ++ai)
#pragma unroll
            for (int m = 0; m < 4; ++m) scv[ai][m] = RS[row0 + ai * HALF + m * 16];
#pragma unroll
        for (int ai = 0; ai < 2; ++ai)
#pragma unroll
            for (int m = 0; m < 4; ++m) scv[ai][m] = __builtin_amdgcn_rsqf(scv[ai][m] * (1.0f / 2048.0f) + 1e-6f);
        asm volatile("" ::: "memory");
#pragma unroll
        for (int ai = 0; ai < 2; ++ai)
#pragma unroll
            for (int m = 0; m < 4; ++m) { bf16_t* rowp = O + (size_t)(row0 + ai * HALF + m * 16) * 5632 + col0;
                float r[8]; const float sc = scv[ai][m];
#pragma unroll
                for (int n = 0; n < 2; ++n)
#pragma unroll
                    for (int j = 0; j < 4; ++j) { const float g = acc[ai][0][m][n][j] * sc, up = acc[ai][1][m][n][j] * sc;
                        const float e = __builtin_amdgcn_exp2f(g * -1.4426950408889634f); r[n * 4 + j] = g * __builtin_amdgcn_rcpf(1.0f + e) * up; }
                u32x4 w; w.x = cvt_pk_bf16(r[0], r[1]); w.y = cvt_pk_bf16(r[2], r[3]); w.z = cvt_pk_bf16(r[4], r[5]); w.w = cvt_pk_bf16(r[6], r[7]);
                *(u32x4*)rowp = w; }
    }
};

template <class Epi, class Sched, bool ALIGN_EPI = false, bool SP2 = false>
__device__ __forceinline__ void gemm_phase(PG8_LAS unsigned char* lds, const Gemm g, const Sched& S, const Epi& E) {
    int tid_ = threadIdx.x; asm volatile("" : "+v"(tid_));
    const int tid = tid_, wid = __builtin_amdgcn_readfirstlane(tid >> 6), lane = tid & 63, wr = wid >> 2, wc = wid & 3, fr = lane & 15, fq = lane >> 4;
    const int K = g.K;
    unsigned voffA[2], voffB[2];
#pragma unroll
    for (int i = 0; i < 2; ++i) { int R, C; stage_rc(tid * 16 + i * 8192, R, C); const int Rb = Epi::PERM ? ((R & ~31) + perm32(R & 31)) : R;
        voffA[i] = (unsigned)(R * K + C) * 2u; voffB[i] = (unsigned)(Rb * K + C) * 2u; }
    const size_t kstep = (size_t)(BK * 2);
    const size_t hstep = (size_t)HALF * K * 2;
    const size_t tstep = 2 * hstep;
    const unsigned ldsw = (unsigned)wid * 1024u;
    const int aoff = lds_byte(wr * 64 + fr, fq * 8), boff = lds_byte(wc * 32 + fr, fq * 8);
#define PG8_SA(b, h) (((b) * 2 + (h)) * HTB)
#define PG8_SB(b, h) ((4 + (b) * 2 + (h)) * HTB)
#define PG8_STAGE(bufoff, gbase, voff) do { _Pragma("unroll") for (int _i = 0; _i < 2; ++_i) \
        __builtin_amdgcn_global_load_lds((const unsigned*)((const char*)(gbase) + (voff)[_i]), (PG8_LAS unsigned*)(lds + (bufoff) + ldsw + _i * 8192), 16, 0, 0); } while (0)
#define PG8_LDA(dst, b, h) do { _Pragma("unroll") for (int m = 0; m < 4; ++m) _Pragma("unroll") for (int k = 0; k < 2; ++k) dst[m][k] = *(const PG8_LAS bf16x8*)(lds + PG8_SA(b, h) + aoff + m * 2048 + k * 1024); } while (0)
#define PG8_LDB(dst, b, h) do { _Pragma("unroll") for (int n = 0; n < 2; ++n) _Pragma("unroll") for (int k = 0; k < 2; ++k) dst[n][k] = *(const PG8_LAS bf16x8*)(lds + PG8_SB(b, h) + boff + n * 2048 + k * 1024); } while (0)
#define PG8_MMA(ai, bj, At, Bt) do { __builtin_amdgcn_s_setprio(1); _Pragma("unroll") for (int m = 0; m < 4; ++m) _Pragma("unroll") for (int n = 0; n < 2; ++n) _Pragma("unroll") for (int k = 0; k < 2; ++k) \
        acc[ai][bj][m][n] = __builtin_amdgcn_mfma_f32_16x16x32_bf16(Bt[n][k], At[m][k], acc[ai][bj][m][n], 0, 0, 0); __builtin_amdgcn_s_setprio(0); } while (0)
#define PG8_WAIT_V(n) asm volatile("s_waitcnt vmcnt(" #n ")" ::: "memory")
#define PG8_WAIT_L(n) asm volatile("s_waitcnt lgkmcnt(" #n ")" ::: "memory")
#define PG8_BAR __builtin_amdgcn_s_barrier()
#define PG8_SCHED __builtin_amdgcn_sched_barrier(0)
    Unit cur, nxt; int ui = 0;
    if (!S.next(0, cur)) return;
    f32x4 acc[2][2][4][2];
#pragma unroll
    for (int a = 0; a < 2; ++a)
#pragma unroll
        for (int b = 0; b < 2; ++b)
#pragma unroll
            for (int m = 0; m < 4; ++m)
#pragma unroll
                for (int n = 0; n < 2; ++n) acc[a][b][m][n] = (f32x4){0.f, 0.f, 0.f, 0.f};
    E.init(acc, cur, wr, wc, fr, fq);
    bf16x8 At[4][2], B0[2][2], B1[2][2];
    const char* cA = (const char*)g.A + (size_t)cur.pm * tstep + (size_t)cur.k0 * kstep; const char* cB = (const char*)g.Bt + (size_t)cur.pn * tstep + (size_t)cur.k0 * kstep;
    S.a_ready(cur);
    if constexpr (SP2) {
        PG8_STAGE(PG8_SB(0, 0), cB, voffB); PG8_STAGE(PG8_SB(0, 1), cB + hstep, voffB); PG8_STAGE(PG8_SA(0, 0), cA, voffA); PG8_STAGE(PG8_SA(0, 1), cA + hstep, voffA);
        if (wr == 1) PG8_BAR;
        PG8_WAIT_V(2); PG8_BAR;
        PG8_STAGE(PG8_SB(1, 0), cB + kstep, voffB); PG8_STAGE(PG8_SA(1, 0), cA + kstep, voffA); PG8_STAGE(PG8_SB(1, 1), cB + hstep + kstep, voffB);
        PG8_WAIT_V(6); PG8_BAR;
    } else {
        PG8_STAGE(PG8_SB(0, 0), cB, voffB); PG8_STAGE(PG8_SA(0, 0), cA, voffA); PG8_STAGE(PG8_SB(0, 1), cB + hstep, voffB); PG8_STAGE(PG8_SA(0, 1), cA + hstep, voffA);
        if (wr == 1) PG8_BAR;
        PG8_WAIT_V(4); PG8_BAR;
        PG8_STAGE(PG8_SB(1, 0), cB + kstep, voffB); PG8_STAGE(PG8_SA(1, 0), cA + kstep, voffA); PG8_STAGE(PG8_SB(1, 1), cB + hstep + kstep, voffB);
        PG8_WAIT_V(6); PG8_BAR;
    }
    for (;;) {
        const bool has_next = S.next(ui + 1, nxt);
        const char* nA = has_next ? (const char*)g.A + (size_t)nxt.pm * tstep + (size_t)nxt.k0 * kstep : cA; const char* nB = has_next ? (const char*)g.Bt + (size_t)nxt.pn * tstep + (size_t)nxt.k0 * kstep : cB;
        const int nt = cur.nt;
        for (int t = 0; t < nt; t += 2) {
            const bool last = (t == nt - 2);
            const char* a1 = cA + (size_t)(t + 1) * kstep;
            const char* a2 = last ? nA : cA + (size_t)(t + 2) * kstep; const char* b2 = last ? nB : cB + (size_t)(t + 2) * kstep;
            const char* a3 = a2 + kstep; const char* b3 = b2 + kstep;
            if (last && has_next) S.a_ready(nxt);
            if constexpr (SP2) {
            PG8_LDB(B0, 0, 0); PG8_LDB(B1, 0, 1); PG8_SCHED; PG8_LDA(At, 0, 0); PG8_STAGE(PG8_SA(1, 1), a1 + hstep, voffA);
            PG8_WAIT_V(8); PG8_WAIT_L(0); PG8_BAR; PG8_MMA(0, 0, At, B0); PG8_MMA(0, 1, At, B1); PG8_BAR; PG8_SCHED;
            PG8_LDA(At, 0, 1); PG8_STAGE(PG8_SB(0, 0), b2, voffB); PG8_STAGE(PG8_SB(0, 1), b2 + hstep, voffB); PG8_STAGE(PG8_SA(0, 0), a2, voffA);
            PG8_WAIT_V(8); PG8_WAIT_L(0); PG8_BAR; PG8_MMA(1, 0, At, B0); PG8_MMA(1, 1, At, B1); PG8_BAR; PG8_SCHED;
            PG8_LDB(B0, 1, 0); PG8_LDB(B1, 1, 1); PG8_SCHED; PG8_LDA(At, 1, 0); PG8_STAGE(PG8_SA(0, 1), a2 + hstep, voffA);
            PG8_WAIT_V(8); PG8_WAIT_L(0); PG8_BAR; PG8_MMA(0, 0, At, B0); PG8_MMA(0, 1, At, B1); PG8_BAR; PG8_SCHED;
            PG8_LDA(At, 1, 1); PG8_STAGE(PG8_SB(1, 0), b3, voffB); PG8_STAGE(PG8_SB(1, 1), b3 + hstep, voffB); PG8_STAGE(PG8_SA(1, 0), a3, voffA);
            PG8_WAIT_V(8); PG8_WAIT_L(0); PG8_BAR; PG8_MMA(1, 0, At, B0); PG8_MMA(1, 1, At, B1); PG8_BAR; PG8_SCHED;
            } else {
            PG8_LDB(B0, 0, 0); PG8_SCHED; PG8_LDA(At, 0, 0); PG8_STAGE(PG8_SA(1, 1), a1 + hstep, voffA);
            PG8_WAIT_L(8); PG8_BAR; PG8_WAIT_L(0); PG8_MMA(0, 0, At, B0); PG8_BAR; PG8_SCHED;
            PG8_LDB(B1, 0, 1); PG8_STAGE(PG8_SB(0, 0), b2, voffB);
            PG8_BAR; PG8_WAIT_L(0); PG8_MMA(0, 1, At, B1); PG8_BAR;
            PG8_LDA(At, 0, 1); PG8_STAGE(PG8_SA(0, 0), a2, voffA);
            PG8_BAR; PG8_WAIT_L(0); PG8_MMA(1, 0, At, B0); PG8_BAR; PG8_SCHED;
            PG8_STAGE(PG8_SB(0, 1), b2 + hstep, voffB);
            PG8_WAIT_V(6); PG8_BAR; PG8_MMA(1, 1, At, B1); PG8_BAR;
            PG8_LDB(B0, 1, 0); PG8_SCHED; PG8_LDA(At, 1, 0); PG8_STAGE(PG8_SA(0, 1), a2 + hstep, voffA);
            PG8_WAIT_L(8); PG8_BAR; PG8_WAIT_L(0); PG8_MMA(0, 0, At, B0); PG8_BAR; PG8_SCHED;
            PG8_LDB(B1, 1, 1); PG8_STAGE(PG8_SB(1, 0), b3, voffB);
            PG8_BAR; PG8_WAIT_L(0); PG8_MMA(0, 1, At, B1); PG8_BAR;
            PG8_LDA(At, 1, 1); PG8_STAGE(PG8_SA(1, 0), a3, voffA);
            PG8_BAR; PG8_WAIT_L(0); PG8_MMA(1, 0, At, B0); PG8_BAR; PG8_SCHED;
            PG8_STAGE(PG8_SB(1, 1), b3 + hstep, voffB);
            PG8_WAIT_V(6); PG8_BAR; PG8_MMA(1, 1, At, B1); PG8_BAR;
            }
        }
        if constexpr (ALIGN_EPI) { if (wr == 0) PG8_BAR; }
        if constexpr (!Epi::AFTER_DRAIN) { E(acc, cur, wr, wc, fr, fq); S.done(cur); }
        if (!has_next) break;
#pragma unroll
        for (int a = 0; a < 2; ++a)
#pragma unroll
            for (int b = 0; b < 2; ++b)
#pragma unroll
                for (int m = 0; m < 4; ++m)
#pragma unroll
                    for (int n = 0; n < 2; ++n) acc[a][b][m][n] = (f32x4){0.f, 0.f, 0.f, 0.f};
        E.init(acc, nxt, wr, wc, fr, fq);
        cur = nxt; cA = nA; cB = nB; ++ui;
        if constexpr (ALIGN_EPI) { if (wr == 1) PG8_BAR; }
    }
    PG8_WAIT_V(0);
    if constexpr (!ALIGN_EPI) { if (wr == 0) PG8_BAR; }
    PG8_BAR;
    if constexpr (Epi::AFTER_DRAIN) { E.fused(acc, cur, wr, wc, fr, fq, lds, wid, lane); S.done(cur); }
#undef PG8_SA
#undef PG8_SB
#undef PG8_STAGE
#undef PG8_LDA
#undef PG8_LDB
#undef PG8_MMA
#undef PG8_WAIT_V
#undef PG8_WAIT_L
#undef PG8_BAR
#undef PG8_SCHED
}
}

#define LAS __attribute__((address_space(3)))
typedef unsigned short bf16;
typedef short bf16x8 __attribute__((ext_vector_type(8)));
typedef float f32x4 __attribute__((ext_vector_type(4)));
typedef unsigned u32x4 __attribute__((ext_vector_type(4)));
typedef unsigned u32x2 __attribute__((ext_vector_type(2)));
constexpr int DM = 2048, NPR = 8192, NSR = 256, MT = NPR + NSR, FF = 5632, TW = 1536, NIN0 = 5120, NIN1 = 2560, NGU = 2 * FF;
constexpr int NTHREADS = 512, NWAVES = 8;
constexpr int LDS_BYTES = 147456, MISC_OFF = LDS_BYTES - 64;
constexpr size_t OUT_CP = (size_t)MT * DM, OUT_CS = OUT_CP + 12288, OUT_WKP = OUT_CS + 98304, OUT_WVP = OUT_WKP + 131072, OUT_WKS = OUT_WVP + 131072,
                 OUT_WVS = OUT_WKS + 1048576, OUT_MK = OUT_WVS + 1048576, OUT_MV = OUT_MK + 1048576, OUT_END = OUT_MV + 1048576;
constexpr size_t MiB = 1u << 20;
constexpr size_t WS_WIN0 = 0, WS_WMEM = 20 * MiB, WS_WIN1 = 28 * MiB, WS_WOUT = 38 * MiB, WS_WGU = 54 * MiB, WS_WDN = 142 * MiB, WS_H = 186 * MiB, WS_MEMH = 219 * MiB,
                 WS_MIX = 227 * MiB, WS_ZA = 260 * MiB, WS_MKV = 351 * MiB, WS_BAR = 355 * MiB, WS_RS = 379 * MiB, WS_RSP = 380 * MiB, WS_PART = 384 * MiB, WS_END = 430 * MiB;
static_assert((size_t)NIN0 * DM * 2 <= WS_WMEM - WS_WIN0 && (size_t)2 * 1024 * DM * 2 <= WS_WIN1 - WS_WMEM && (size_t)NIN1 * DM * 2 <= WS_WOUT - WS_WIN1 && (size_t)2 * DM * DM * 2 <= WS_WGU - WS_WOUT &&
              (size_t)2 * NGU * DM * 2 <= WS_WDN - WS_WGU && (size_t)2 * DM * FF * 2 <= WS_H - WS_WDN && (size_t)MT * DM * 2 <= WS_MEMH - WS_H && (size_t)2 * 1024 * DM * 2 <= WS_MIX - WS_MEMH &&
              (size_t)MT * DM * 2 <= WS_ZA - WS_MIX && (size_t)MT * FF * 2 <= WS_MKV - WS_ZA && (size_t)MT * NIN0 * 2 <= WS_MKV - WS_ZA && (size_t)2 * 1024 * 1024 * 2 <= WS_BAR - WS_MKV, "d_ws map");

struct Params { const float* in[22]; float* out; unsigned char* ws; };
enum { I_XP = 0, I_XS, I_MEMP, I_SCONV, I_CWK, I_CWV, I_CMK, I_CMV, I_NMIX, I_NMEM, I_WMEMKV, I_NFFN, I_WGATE, I_WUP, I_WDOWN, I_CWIN, I_CW, I_CWOUT, I_AWIN, I_SINKS, I_AWOUT, I_NFINAL };

__device__ __forceinline__ unsigned f2bf(float f) { unsigned u = __builtin_bit_cast(unsigned, f); return (u + 0x7fffu + ((u >> 16) & 1u)) >> 16; }
__device__ __forceinline__ unsigned pk2(float lo, float hi) { return f2bf(lo) | (f2bf(hi) << 16); }
__device__ __forceinline__ float bf_lo(unsigned w) { return __builtin_bit_cast(float, w << 16); }
__device__ __forceinline__ float bf_hi(unsigned w) { return __builtin_bit_cast(float, w & 0xffff0000u); }
__device__ __forceinline__ float wave_sum(float v) {
#pragma unroll
    for (int o = 1; o < 64; o <<= 1) v += __shfl_xor(v, o);
    return v;
}
#define LDS_WAIT() asm volatile("s_waitcnt lgkmcnt(0)" ::: "memory")
__device__ __forceinline__ int otid() { int t = threadIdx.x; asm volatile("" : "+v"(t)); return t; }

#define XB_TMO      128
#define XB_XCNT(j)  (256  + 64 * (j))
#define XB_XSUB(j)  (1280 + 64 * (j))
#define XB_XGEN(j)  (2304 + 64 * (j))
#define XB_TOP      3328
#define XB_TOPGEN   3392
#define XCD_BAR_WORDS 3456
#define XB_SPIN_CAP (1u << 18)

__device__ __forceinline__ unsigned xb_ld(unsigned* p)              { return __hip_atomic_load(p, __ATOMIC_RELAXED, __HIP_MEMORY_SCOPE_AGENT); }
__device__ __forceinline__ unsigned xb_add(unsigned* p, unsigned v) { return __hip_atomic_fetch_add(p, v, __ATOMIC_RELAXED, __HIP_MEMORY_SCOPE_AGENT); }
__device__ __forceinline__ unsigned xb_xcc_id() { return (unsigned)__builtin_amdgcn_s_getreg((3 << 11) | 20) & 0xFu; }
#define XB_SPIN(cond, bar) do { unsigned _sp = 0; while (cond) { __builtin_amdgcn_s_sleep(1); \
    if ((++_sp & 255u) == 0u) { if (xb_ld(&(bar)[XB_TMO])) break; if (_sp > XB_SPIN_CAP) { atomicAdd(&(bar)[XB_TMO], 1u); break; } } } } while (0)

struct XcdBarrier {
    unsigned* bar; unsigned x;
    volatile LAS unsigned* st;
};

__device__ __forceinline__ XcdBarrier xcd_barrier_post(unsigned* bar, volatile LAS unsigned* st) {
    XcdBarrier b; b.bar = bar; b.x = xb_xcc_id(); b.st = st;
    if (threadIdx.x == 0) (void)xb_add(&bar[XB_XCNT(b.x)], 1u);
    return b;
}
__device__ __forceinline__ void xcd_barrier_complete(unsigned* bar, unsigned x, unsigned& nloc, unsigned& nx) {
    const unsigned G = gridDim.x * gridDim.y * gridDim.z;
    unsigned sum, cnt, mine, sp = 0u;
    for (;;) {
        sum = 0u; cnt = 0u; mine = 0u;
#pragma unroll
        for (unsigned j = 0; j < 16; ++j) { const unsigned c = xb_ld(&bar[XB_XCNT(j)]); sum += c; cnt += (c > 0u) ? 1u : 0u; mine = (j == x) ? c : mine; }
        if (sum == G) break;
        __builtin_amdgcn_s_sleep(1);
        if ((++sp & 255u) == 0u) { if (xb_ld(&bar[XB_TMO])) break; if (sp > XB_SPIN_CAP) { atomicAdd(&bar[XB_TMO], 1u); break; } }
    }
    nloc = mine > 0u ? mine : 1u; nx = cnt > 0u ? cnt : 1u;
}

__device__ __forceinline__ void xcd_barrier(const XcdBarrier& b) {
    asm volatile("s_waitcnt vmcnt(0)" ::: "memory");
    __syncthreads();
    if (threadIdx.x == 0) {
        unsigned* bar = b.bar;
        __builtin_amdgcn_s_waitcnt(0);
        unsigned nloc = b.st[0], nx = b.st[1];
        if (nloc == 0u) { xcd_barrier_complete(bar, b.x, nloc, nx); b.st[0] = nloc; b.st[1] = nx; }
        const unsigned old = xb_add(&bar[XB_XSUB(b.x)], 1u);
        const unsigned gen = old / nloc;
        if (old + 1u == (gen + 1u) * nloc) {
            __builtin_amdgcn_fence(__ATOMIC_RELEASE, "agent");
            asm volatile("s_waitcnt vmcnt(0)" ::: "memory");
            const unsigned og = xb_add(&bar[XB_TOP], 1u);
            const unsigned tg = og / nx;
            if (og + 1u == (tg + 1u) * nx) xb_add(&bar[XB_TOPGEN], 1u);
            else XB_SPIN(xb_ld(&bar[XB_TOPGEN]) == tg, bar);
            __builtin_amdgcn_fence(__ATOMIC_ACQUIRE, "agent");
            xb_add(&bar[XB_XGEN(b.x)], 1u);
            asm volatile("s_waitcnt vmcnt(0)" ::: "memory");
        } else {
            XB_SPIN(xb_ld(&bar[XB_XGEN(b.x)]) == gen, bar);
            __builtin_amdgcn_fence(__ATOMIC_ACQUIRE, "agent");
            asm volatile("s_waitcnt vmcnt(0)" ::: "memory");
        }
    }
    __syncthreads();
}

struct TItem { const float* W; bf16* WT; const float* gk; int K, N, k0, n0, d0; };
__device__ __forceinline__ void titem_load(const TItem& t, float (&wv)[32], int lane) {
#pragma unroll
    for (int i = 0; i < 32; ++i) wv[i] = t.W[(size_t)(t.k0 + 2 * i + (lane >> 5)) * t.N + t.n0 + (lane & 31)];
}
__device__ __forceinline__ void titem_copy(float (&d)[32], const float (&s)[32]) {
#pragma unroll
    for (int i = 0; i < 32; ++i) d[i] = s[i];
}
__device__ __forceinline__ void titem_store(const TItem& t, const float (&wv)[32], LAS float* scr, int lane) {
    const int c = lane & 7;
    f32x4 ga = (f32x4){1.f, 1.f, 1.f, 1.f}, gb = ga;
    if (t.gk) { ga = *(const f32x4*)(t.gk + t.k0 + 8 * c); gb = *(const f32x4*)(t.gk + t.k0 + 8 * c + 4); }
#pragma unroll
    for (int i = 0; i < 32; ++i) scr[(2 * i + (lane >> 5)) * 33 + (lane & 31)] = wv[i];
    LDS_WAIT(); asm volatile("" ::: "memory");
#pragma unroll
    for (int j = 0; j < 4; ++j) { const int n = (lane >> 3) + 8 * j; const LAS float* s = scr + (8 * c) * 33 + n;
        u32x4 o; o.x = pk2(s[0 * 33] * ga.x, s[1 * 33] * ga.y); o.y = pk2(s[2 * 33] * ga.z, s[3 * 33] * ga.w); o.z = pk2(s[4 * 33] * gb.x, s[5 * 33] * gb.y); o.w = pk2(s[6 * 33] * gb.z, s[7 * 33] * gb.w);
        *(u32x4*)(t.WT + (size_t)(t.d0 + n) * t.K + t.k0 + 8 * c) = o; }
    LDS_WAIT(); asm volatile("" ::: "memory");
}
constexpr size_t PSTRIDE = (size_t)256 * 2048;
__device__ __forceinline__ float load_row_sumsq(f32x4 (&v)[8], const float* xrow, float* xw, const float* part, int npart, int lane) {
    const f32x4* xr = (const f32x4*)xrow + lane; float s = 0.f;
#pragma unroll
    for (int j = 0; j < 8; ++j) v[j] = xr[64 * j];
    if (npart > 0) {
        for (int q = 0; q < npart; ++q) { const f32x4* pr = (const f32x4*)(part + (size_t)q * PSTRIDE) + lane;
#pragma unroll
            for (int j = 0; j < 8; ++j) v[j] += pr[64 * j]; }
        f32x4* xo = (f32x4*)xw + lane;
#pragma unroll
        for (int j = 0; j < 8; ++j) xo[64 * j] = v[j];
    }
#pragma unroll
    for (int j = 0; j < 8; ++j) s += (v[j].x * v[j].x + v[j].y * v[j].y) + (v[j].z * v[j].z + v[j].w * v[j].w);
    return wave_sum(s);
}
__device__ __forceinline__ void rms_row_bf16(const float* xrow, float* xw, const float* part, int npart, const float* g, bf16* orow, int lane) {
    f32x4 v[8]; const float r = 1.0f / sqrtf(load_row_sumsq(v, xrow, xw, part, npart, lane) * (1.0f / DM) + 1e-6f);
    const f32x4* gr = (const f32x4*)g + lane; u32x2* o8 = (u32x2*)orow + lane;
#pragma unroll
    for (int j = 0; j < 8; ++j) { const f32x4 gg = gr[64 * j]; u32x2 w; w.x = pk2(v[j].x * r * gg.x, v[j].y * r * gg.y); w.y = pk2(v[j].z * r * gg.z, v[j].w * r * gg.w); o8[64 * j] = w; }
}
__device__ __forceinline__ void fixup_phase(float* X, const float* part, int npart, bf16* XB, float* RS, const float* RSP, LAS float* red, int bx, int G, int tid) {
    const int lane = tid & 63, wave = tid >> 6;
    for (int r = bx; r < NSR; r += G) {
        const size_t o = (size_t)(NPR + r) * DM + wave * 256 + lane * 4;
        f32x4 v = *(const f32x4*)(X + o);
        const bf16* pp = (const bf16*)part + (size_t)r * DM + wave * 256 + lane * 4;
        f32x4 q[22];
#pragma unroll
        for (int i = 0; i < 22; ++i) { if (i < npart) { const u32x2 w = *(const u32x2*)(pp + (size_t)i * PSTRIDE); q[i] = (f32x4){bf_lo(w.x), bf_hi(w.x), bf_lo(w.y), bf_hi(w.y)}; } else q[i] = (f32x4){0.f, 0.f, 0.f, 0.f}; }
#pragma unroll
        for (int i = 0; i < 22; ++i) v += q[i];
        *(f32x4*)(X + o) = v;
        u32x2 w; w.x = pk2(v.x, v.y); w.y = pk2(v.z, v.w); *(u32x2*)(XB + o) = w;
        const float ss = wave_sum((v.x * v.x + v.y * v.y) + (v.z * v.z + v.w * v.w));
        __syncthreads();
        if (lane == 0) red[wave] = ss;
        __syncthreads();
        if (tid == 0) RS[NPR + r] = ((red[0] + red[1]) + (red[2] + red[3])) + ((red[4] + red[5]) + (red[6] + red[7]));
    }
    for (int i = bx * NTHREADS + tid; i < NPR * 16; i += G * NTHREADS) {
        const int row = i >> 4, sub = i & 15;
        float s = RSP[(size_t)sub * MT + row] + RSP[(size_t)(sub + 16) * MT + row];
        s += __shfl_xor(s, 1); s += __shfl_xor(s, 2); s += __shfl_xor(s, 4); s += __shfl_xor(s, 8);
        if (sub == 0) RS[row] = s;
    }
}
__device__ __forceinline__ void final_sample_rows(float* X, const float* part, int npart, const float* g, LAS float* red, int bx, int G, int tid) {
    const int lane = tid & 63, wave = tid >> 6;
    for (int r = bx; r < NSR; r += G) {
        const size_t o = (size_t)(NPR + r) * DM + wave * 256 + lane * 4;
        f32x4 v = *(const f32x4*)(X + o);
        const bf16* pp = (const bf16*)part + (size_t)r * DM + wave * 256 + lane * 4;
        f32x4 q[22];
#pragma unroll
        for (int i = 0; i < 22; ++i) { if (i < npart) { const u32x2 w = *(const u32x2*)(pp + (size_t)i * PSTRIDE); q[i] = (f32x4){bf_lo(w.x), bf_hi(w.x), bf_lo(w.y), bf_hi(w.y)}; } else q[i] = (f32x4){0.f, 0.f, 0.f, 0.f}; }
        const f32x4 gg = *(const f32x4*)(g + wave * 256 + lane * 4);
#pragma unroll
        for (int i = 0; i < 22; ++i) v += q[i];
        const float ss = wave_sum((v.x * v.x + v.y * v.y) + (v.z * v.z + v.w * v.w));
        __syncthreads();
        if (lane == 0) red[wave] = ss;
        __syncthreads();
        const float tot = ((red[0] + red[1]) + (red[2] + red[3])) + ((red[4] + red[5]) + (red[6] + red[7]));
        const float rinv = 1.0f / sqrtf(tot * (1.0f / DM) + 1e-6f);
        *(f32x4*)(X + o) = v * rinv * gg;
    }
}
template <int NR> __device__ __forceinline__ void rms_rows_from_bf16(const bf16* XB, int m0, int mstride, int mend, const float* g, float* Y, int lane) {
    u32x2 raw[NR][8];
#pragma unroll
    for (int k = 0; k < NR; ++k) { const int m = m0 + k * mstride; if (m < mend) { const u32x2* xr = (const u32x2*)(XB + (size_t)m * DM) + lane;
#pragma unroll
            for (int j = 0; j < 8; ++j) raw[k][j] = xr[64 * j]; } }
    const f32x4* gr = (const f32x4*)g + lane;
#pragma unroll
    for (int k = 0; k < NR; ++k) { const int m = m0 + k * mstride; if (m < mend) {
            f32x4 v[8]; float s = 0.f;
#pragma unroll
            for (int j = 0; j < 8; ++j) { const u32x2 w = raw[k][j]; v[j] = (f32x4){bf_lo(w.x), bf_hi(w.x), bf_lo(w.y), bf_hi(w.y)}; s += (v[j].x * v[j].x + v[j].y * v[j].y) + (v[j].z * v[j].z + v[j].w * v[j].w); }
            const float r = 1.0f / sqrtf(wave_sum(s) * (1.0f / DM) + 1e-6f);
            f32x4* yo = (f32x4*)(Y + (size_t)m * DM) + lane;
#pragma unroll
            for (int j = 0; j < 8; ++j) { const f32x4 gg = gr[64 * j]; yo[64 * j] = v[j] * r * gg; } } }
}
__device__ __forceinline__ void rms_row_from_bf16(const bf16* xb, const float* g, float* yrow, int lane) {
    const u32x2* xr = (const u32x2*)xb + lane; f32x4 v[8]; float s = 0.f;
#pragma unroll
    for (int j = 0; j < 8; ++j) { const u32x2 w = xr[64 * j]; v[j] = (f32x4){bf_lo(w.x), bf_hi(w.x), bf_lo(w.y), bf_hi(w.y)}; }
#pragma unroll
    for (int j = 0; j < 8; ++j) s += (v[j].x * v[j].x + v[j].y * v[j].y) + (v[j].z * v[j].z + v[j].w * v[j].w);
    const float r = 1.0f / sqrtf(wave_sum(s) * (1.0f / DM) + 1e-6f);
    f32x4* yo = (f32x4*)yrow + lane; const f32x4* gr = (const f32x4*)g + lane;
#pragma unroll
    for (int j = 0; j < 8; ++j) { const f32x4 gg = gr[64 * j]; yo[64 * j] = v[j] * r * gg; }
}
__device__ __forceinline__ void raw_row_bf16(const float* xrow, bf16* orow, float* rs, int lane) {
    const f32x4* xr = (const f32x4*)xrow + lane; f32x4 v[8]; float s = 0.f;
#pragma unroll
    for (int j = 0; j < 8; ++j) v[j] = xr[64 * j];
#pragma unroll
    for (int j = 0; j < 8; ++j) s += (v[j].x * v[j].x + v[j].y * v[j].y) + (v[j].z * v[j].z + v[j].w * v[j].w);
    s = wave_sum(s);
    u32x2* o8 = (u32x2*)orow + lane;
#pragma unroll
    for (int j = 0; j < 8; ++j) { u32x2 w; w.x = pk2(v[j].x, v[j].y); w.y = pk2(v[j].z, v[j].w); o8[64 * j] = w; }
    if (lane == 0) *rs = s;
}
__device__ __forceinline__ void rms_row_f32_inplace(float* xrow, const float* part, int npart, const float* g, int lane) {
    f32x4 v[8]; const float r = 1.0f / sqrtf(load_row_sumsq(v, xrow, xrow, part, npart, lane) * (1.0f / DM) + 1e-6f);
    f32x4* xr = (f32x4*)xrow + lane; const f32x4* gr = (const f32x4*)g + lane;
#pragma unroll
    for (int j = 0; j < 8; ++j) { const f32x4 gg = gr[64 * j]; xr[64 * j] = v[j] * r * gg; }
}

struct KVDesc { const bf16* kb; const bf16* vb; const float* kf; const float* vf; int strideb, stridef, n_f32, n_b16, zero_lo; };
__device__ __forceinline__ int vpos(int key) { return (key & ~31) + (((key & 15) >> 2) << 3) + (key & 3) + (((key >> 4) & 1) << 2); }
template <int D> __device__ __forceinline__ void attn_load_kv(LAS unsigned char* lds, const KVDesc& kv, int tid) {
    constexpr int KSTR = D * 2 + 16, VSTR = 528, CH = D / 8, VT_OFF = 256 * KSTR;
#pragma unroll 1
    for (int idx = tid; idx < 64 * CH; idx += NTHREADS) {
        const int blk = idx >> 6, key0 = ((blk & 3) * 16 + (idx & 15)) * 4, c = (blk >> 2) * 4 + ((idx >> 4) & 3);
        u32x4 kk[4], vv[4];
#pragma unroll
        for (int i = 0; i < 4; ++i) {
            const int key = key0 + i;
            kk[i] = (u32x4){0u, 0u, 0u, 0u}; vv[i] = (u32x4){0u, 0u, 0u, 0u};
            if (key >= kv.zero_lo && key < kv.n_f32 + kv.n_b16) {
                if (key < kv.n_f32) {
                    const f32x4* ks = (const f32x4*)(kv.kf + (size_t)key * kv.stridef + c * 8); const f32x4* vs = (const f32x4*)(kv.vf + (size_t)key * kv.stridef + c * 8);
                    const f32x4 a = ks[0], b = ks[1], e = vs[0], f = vs[1];
                    kk[i].x = pk2(a.x, a.y); kk[i].y = pk2(a.z, a.w); kk[i].z = pk2(b.x, b.y); kk[i].w = pk2(b.z, b.w);
                    vv[i].x = pk2(e.x, e.y); vv[i].y = pk2(e.z, e.w); vv[i].z = pk2(f.x, f.y); vv[i].w = pk2(f.z, f.w);
                } else {
                    kk[i] = *(const u32x4*)(kv.kb + (long)(key - kv.n_f32) * kv.strideb + c * 8); vv[i] = *(const u32x4*)(kv.vb + (long)(key - kv.n_f32) * kv.strideb + c * 8);
                }
            }
        }
#pragma unroll
        for (int i = 0; i < 4; ++i) *(LAS u32x4*)(lds + (key0 + i) * KSTR + c * 16) = kk[i];
        LAS unsigned char* vb = lds + VT_OFF + (c * 8) * VSTR + vpos(key0) * 2;
#pragma unroll
        for (int w = 0; w < 4; ++w) {
            u32x2 lo, hi;
            lo.x = (vv[0][w] & 0xffffu) | (vv[1][w] << 16); lo.y = (vv[2][w] & 0xffffu) | (vv[3][w] << 16);
            hi.x = (vv[0][w] >> 16) | (vv[1][w] & 0xffff0000u); hi.y = (vv[2][w] >> 16) | (vv[3][w] & 0xffff0000u);
            *(LAS u32x2*)(vb + (2 * w) * VSTR) = lo; *(LAS u32x2*)(vb + (2 * w + 1) * VSTR) = hi;
        }
    }
}
template <int D> __device__ __forceinline__ void attn_loadq(bf16x8 (&qf)[D / 32], const bf16* qrow, int lane) {
#pragma unroll
    for (int kk = 0; kk < D / 32; ++kk) qf[kk] = *(const bf16x8*)(qrow + 32 * kk + 8 * (lane >> 4));
}
template <int D, bool BAND> __device__ __forceinline__ void attn16(const LAS unsigned char* lds, const bf16x8 (&qf)[D / 32], bf16* orow, bool row_valid, int qi, bool prev_valid, float sinkl2, int kt_lo, int kt_hi, int lane) {
    constexpr int KSTR = D * 2 + 16, VSTR = 528, NKK = D / 32, NDT = D / 16, VT_OFF = 256 * KSTR;
    const int fr = lane & 15, fq = lane >> 4;
    const float NEGI = -__builtin_inff();
    f32x4 s[16];
#pragma unroll
    for (int kt = 0; kt < 16; ++kt) {
        if (!BAND || (kt >= kt_lo && kt <= kt_hi)) { s[kt] = (f32x4){0.f, 0.f, 0.f, 0.f};
#pragma unroll
            for (int kk = 0; kk < NKK; ++kk) { const bf16x8 kf = *(const LAS bf16x8*)(lds + (16 * kt + fr) * KSTR + (32 * kk + 8 * fq) * 2);
                s[kt] = __builtin_amdgcn_mfma_f32_16x16x32_bf16(kf, qf[kk], s[kt], 0, 0, 0); }
        } else s[kt] = (f32x4){NEGI, NEGI, NEGI, NEGI}; }
    const float cs = (D == 128 ? 0.08838834764831845f : 0.125f) * 1.4426950408889634f;
    const float NEG = -__builtin_inff();
    float mx = NEG;
#pragma unroll
    for (int kt = 0; kt < 16; ++kt)
#pragma unroll
        for (int r = 0; r < 4; ++r) { float v = s[kt][r] * cs;
            if (BAND) { const int kj = 16 * kt + 4 * fq + r; const bool ok = (kj > qi) && (kj <= qi + 128) && (prev_valid || kj >= 128); v = ok ? v : NEG; }
            s[kt][r] = v; mx = fmaxf(mx, v); }
    mx = fmaxf(mx, __shfl_xor(mx, 16)); mx = fmaxf(mx, __shfl_xor(mx, 32));
    if (BAND) mx = fmaxf(mx, sinkl2);
    float sum = 0.f;
#pragma unroll
    for (int kt = 0; kt < 16; ++kt)
#pragma unroll
        for (int r = 0; r < 4; ++r) { const float e = __builtin_amdgcn_exp2f(s[kt][r] - mx); s[kt][r] = e; sum += e; }
    sum += __shfl_xor(sum, 16); sum += __shfl_xor(sum, 32);
    if (BAND) sum += __builtin_amdgcn_exp2f(sinkl2 - mx);
    const float inv = 1.0f / sum;
    f32x4 o[NDT];
#pragma unroll
    for (int dt = 0; dt < NDT; ++dt) o[dt] = (f32x4){0.f, 0.f, 0.f, 0.f};
#pragma unroll
    for (int sl = 0; sl < 8; ++sl) {
        if (BAND && (2 * sl + 1 < kt_lo || 2 * sl > kt_hi)) continue;
        u32x4 pw; pw.x = pk2(s[2 * sl][0], s[2 * sl][1]); pw.y = pk2(s[2 * sl][2], s[2 * sl][3]); pw.z = pk2(s[2 * sl + 1][0], s[2 * sl + 1][1]); pw.w = pk2(s[2 * sl + 1][2], s[2 * sl + 1][3]);
        const bf16x8 pf = __builtin_bit_cast(bf16x8, pw);
#pragma unroll
        for (int dt = 0; dt < NDT; ++dt) { const bf16x8 vf = *(const LAS bf16x8*)(lds + VT_OFF + (16 * dt + fr) * VSTR + (32 * sl + 8 * fq) * 2);
            o[dt] = __builtin_amdgcn_mfma_f32_16x16x32_bf16(vf, pf, o[dt], 0, 0, 0); } }
    if (row_valid) {
#pragma unroll
        for (int dt = 0; dt < NDT; ++dt) { u32x2 w; w.x = pk2(o[dt][0] * inv, o[dt][1] * inv); w.y = pk2(o[dt][2] * inv, o[dt][3] * inv); *(u32x2*)(orow + 16 * dt + 4 * fq) = w; }
    }
}

__global__ void __launch_bounds__(NTHREADS, 2) fwd_megakernel(Params p) {
    extern __shared__ __attribute__((aligned(16))) unsigned char lds_raw[];
    LAS unsigned char* lds = (LAS unsigned char*)lds_raw;
    cg::grid_group grid = cg::this_grid();
    const int G = gridDim.x, bx = blockIdx.x, NGW = G * NWAVES;
#define PHASE_IDS() const int tid = otid(), lane = tid & 63, wave = __builtin_amdgcn_readfirstlane(tid >> 6), gw = bx * NWAVES + wave; (void)lane; (void)gw
    unsigned char* ws = p.ws;
    float* out = p.out;
    bf16* WIN0 = (bf16*)(ws + WS_WIN0); bf16* WMEM = (bf16*)(ws + WS_WMEM); bf16* WIN1 = (bf16*)(ws + WS_WIN1); bf16* WOUT = (bf16*)(ws + WS_WOUT);
    bf16* WGU = (bf16*)(ws + WS_WGU); bf16* WDN = (bf16*)(ws + WS_WDN); bf16* H = (bf16*)(ws + WS_H); bf16* MEMH = (bf16*)(ws + WS_MEMH);
    bf16* MIX = (bf16*)(ws + WS_MIX); bf16* ZA = (bf16*)(ws + WS_ZA); bf16* MKV = (bf16*)(ws + WS_MKV);
    float* X = out;
    float* PART = (float*)(ws + WS_PART);
    float* RSP = (float*)(ws + WS_RSP);
    float* RS = (float*)(ws + WS_RS);
    constexpr int SNT_OUT = 4, NSL_OUT = (DM / 64) / SNT_OUT, SNT_DN = 8, NSL_DN = (FF / 64) / SNT_DN;
    unsigned* barw = (unsigned*)(ws + WS_BAR);
    volatile LAS unsigned* MISC = (volatile LAS unsigned*)(lds + MISC_OFF);
    { const int t0 = otid(); if (bx == 0) for (int i = t0; i < XCD_BAR_WORDS; i += NTHREADS) barw[i] = 0u; if (t0 < 2) MISC[t0] = 0u; }
    __syncthreads();

    constexpr int I_IN0 = (DM / 64) * (NIN0 / 32), I_MEM = (DM / 64) * (1024 / 32), I_IN1 = (DM / 64) * (NIN1 / 32), I_OUT = (DM / 64) * (DM / 32), I_GU = (DM / 64) * (FF / 32), I_DN = (FF / 64) * (DM / 32);
    constexpr int NP0 = I_IN0 + 2 * I_MEM + I_IN1 + I_OUT + 2 * I_GU + I_DN, NITEMS = NP0 + I_OUT + 2 * I_GU + I_DN;
#ifndef DQ_
#define DQ_ 5
#endif
    constexpr int DQ = DQ_, DEF_A = 76 * 8 * DQ, DEF_B = 84 * 8 * DQ, DEF_C = 182 * 8 * DQ;
    constexpr int DEF0 = (NITEMS - DEF_A - DEF_B - DEF_C) > NP0 ? (NITEMS - DEF_A - DEF_B - DEF_C) : NP0;
    const bool defer = (G == 256);
#define GET_ITEM(it_, T) do { int r = (it_); int mode = 0; (T).gk = nullptr; (T).K = DM; \
            if (r < I_IN0) { (T).W = p.in[I_CWIN]; (T).WT = WIN0; (T).N = NIN0; (T).gk = p.in[I_NMIX]; } \
            else if ((r -= I_IN0) < I_MEM) { (T).W = p.in[I_WMEMKV]; (T).WT = WMEM; (T).N = 1024; } \
            else if ((r -= I_MEM) < I_MEM) { (T).W = p.in[I_WMEMKV] + (size_t)DM * 1024; (T).WT = WMEM + (size_t)1024 * DM; (T).N = 1024; } \
            else if ((r -= I_MEM) < I_IN1) { (T).W = p.in[I_AWIN]; (T).WT = WIN1; (T).N = NIN1; (T).gk = p.in[I_NMIX] + DM; } \
            else if ((r -= I_IN1) < I_OUT) { (T).W = p.in[I_CWOUT]; (T).WT = WOUT; (T).N = DM; } \
            else if ((r -= I_OUT) < I_GU) { (T).W = p.in[I_WGATE]; (T).WT = WGU; (T).N = FF; mode = 1; (T).gk = p.in[I_NFFN]; } \
            else if ((r -= I_GU) < I_GU) { (T).W = p.in[I_WUP]; (T).WT = WGU; (T).N = FF; mode = 2; (T).gk = p.in[I_NFFN]; } \
            else if ((r -= I_GU) < I_DN) { (T).W = p.in[I_WDOWN]; (T).WT = WDN; (T).N = DM; (T).K = FF; } \
            else if ((r -= I_DN) < I_OUT) { (T).W = p.in[I_AWOUT]; (T).WT = WOUT + (size_t)DM * DM; (T).N = DM; } \
            else if ((r -= I_OUT) < I_GU) { (T).W = p.in[I_WGATE] + (size_t)DM * FF; (T).WT = WGU + (size_t)NGU * DM; (T).N = FF; mode = 1; (T).gk = p.in[I_NFFN] + DM; } \
            else if ((r -= I_GU) < I_GU) { (T).W = p.in[I_WUP] + (size_t)DM * FF; (T).WT = WGU + (size_t)NGU * DM; (T).N = FF; mode = 2; (T).gk = p.in[I_NFFN] + DM; } \
            else { r -= I_GU; (T).W = p.in[I_WDOWN] + (size_t)FF * DM; (T).WT = WDN + (size_t)DM * FF; (T).N = DM; (T).K = FF; } \
            const int nblk = (T).N / 32, kb = r / nblk, nb = r % nblk; (T).n0 = 32 * nb; (T).k0 = 64 * kb; \
            (T).d0 = mode == 0 ? (T).n0 : (256 * ((T).n0 >> 7) + ((T).n0 & 127) + (mode == 2 ? 128 : 0)); } while (0)
#define LOCAL_PTRS() const Params* pp_ = (const Params*)__builtin_amdgcn_kernarg_segment_ptr(); asm volatile("" : "+s"(pp_)); const Params& p = *pp_; unsigned char* ws = p.ws; \
        bf16* WIN0 = (bf16*)(ws + WS_WIN0); bf16* WMEM = (bf16*)(ws + WS_WMEM); bf16* WIN1 = (bf16*)(ws + WS_WIN1); bf16* WOUT = (bf16*)(ws + WS_WOUT); bf16* WGU = (bf16*)(ws + WS_WGU); bf16* WDN = (bf16*)(ws + WS_WDN); \
        (void)WIN0; (void)WMEM; (void)WIN1; (void)WOUT; (void)WGU; (void)WDN
#define CONVERT_SIMPLE(first_, stride_, count_, end_) do { LAS float* scr_ = (LAS float*)(lds + wave * 16384); \
            for (int j_ = 0, it = (first_); j_ < (count_) && it < (end_); ++j_, it += (stride_)) { TItem cur; float wv[32]; GET_ITEM(it, cur); titem_load(cur, wv, lane); titem_store(cur, wv, scr_, lane); } } while (0)
#define CONVERT_ITEMS(first_, stride_, count_, end_) do { LAS float* scr_ = (LAS float*)(lds + wave * 16384); \
            TItem cur, nxt; float wv[32], wn[32]; int it = (first_), left = (count_); const int stride = (stride_), end = (end_); \
            if (it < end && left > 0) { GET_ITEM(it, cur); titem_load(cur, wv, lane); } \
            while (it < end && left > 0) { \
                const int itn = it + stride; const bool hn = itn < end && left > 1; \
                if (hn) { GET_ITEM(itn, nxt); titem_load(nxt, wn, lane); } \
                titem_store(cur, wv, scr_, lane); \
                if (hn) { cur = nxt; titem_copy(wv, wn); } \
                it = itn; --left; } } while (0)
    {
        PHASE_IDS();
        CONVERT_ITEMS(gw, NGW, (1 << 30), defer ? DEF0 : NITEMS);

        for (int i = bx * NTHREADS + tid; i < NSR * DM / 4; i += G * NTHREADS) ((f32x4*)(X + (size_t)NPR * DM))[i] = ((const f32x4*)p.in[I_XS])[i];
        for (int m = gw; m < 2048; m += NGW) { const int li = m >> 10, r = m & 1023; rms_row_bf16(p.in[I_MEMP] + (size_t)r * DM, nullptr, nullptr, 0, p.in[I_NMEM] + li * DM, MEMH + (size_t)m * DM, lane); }
        for (int m = gw; m < MT; m += NGW) { const float* xr = m < NPR ? p.in[I_XP] + (size_t)m * DM : p.in[I_XS] + (size_t)(m - NPR) * DM; raw_row_bf16(xr, H + (size_t)m * DM, RS + (size_t)3 * MT + m, lane); }
    }
    grid.sync();
    const XcdBarrier xbar = xcd_barrier_post(barw, MISC);

#pragma unroll 1
    for (int li = 0; li < 2; ++li) {
        const int NIN = li ? NIN1 : NIN0;
        const int QMOFF = li ? 2048 : 4608;
        bf16* Z = ZA;
        if (li == 0) {
            pg8::Gemm g{MEMH, WMEM, 2048, 2048, DM}; pg8::MemOrder S{G, (bx + G - (200 % G)) % G};
            pg8::EpiMem E{out + OUT_MK, out + OUT_MV, MKV};
            pg8::gemm_phase<pg8::EpiMem, pg8::MemOrder, true, true>(lds, g, S, E);
        }

        {
            pg8::Gemm g{H, li ? WIN1 : WIN0, MT, NIN, DM}; pg8::StaticOrder S; S.init(MT, NIN, G, bx, DM);
            pg8::EpiZ E{Z, NIN, li ? RS + MT : RS + (size_t)3 * MT};
            pg8::gemm_phase<pg8::EpiZ, pg8::StaticOrder, true, true>(lds, g, S, E);
        }
        if (defer) {
            PHASE_IDS();
            if (li == 0) { const int r = (bx >= 148 && bx < 200) ? bx - 148 : (bx >= 232 ? 52 + bx - 232 : -1);
                if (r >= 0) CONVERT_SIMPLE(DEF0 + r * 8 + wave, 76 * 8, DQ, DEF0 + DEF_A); }
            else if (bx >= 74) CONVERT_SIMPLE(DEF0 + DEF_A + DEF_B + (bx - 74) * 8 + wave, 182 * 8, DQ, NITEMS);
        }

        xcd_barrier(xbar);
        {
            PHASE_IDS();
            for (int u = bx; u < 256; u += G) {
                KVDesc kv; int row0, h, niter; bool valid;
                if (u < 128) { const int b = u >> 5; h = (u >> 3) & 3; const int ch = u & 7;
                    kv.kb = MKV + (size_t)li * 1048576 + (size_t)(b * 256) * 1024 + h * 128; kv.vb = kv.kb + 512; kv.kf = nullptr; kv.vf = nullptr; kv.strideb = 1024; kv.stridef = 0; kv.n_f32 = 0; kv.n_b16 = 256; kv.zero_lo = 0;
                    row0 = b * 2048 + ch * 256 + wave * 32 + (lane & 15); valid = true; niter = 2;
                } else { const int s = u - 128, b = s >> 2; h = s & 3;
                    kv.kf = p.in[I_CMK] + (size_t)((li * 32 + b) * 256) * 512 + h * 128; kv.vf = p.in[I_CMV] + (size_t)((li * 32 + b) * 256) * 512 + h * 128; kv.kb = nullptr; kv.vb = nullptr; kv.strideb = 0; kv.stridef = 512; kv.n_f32 = 256; kv.n_b16 = 0; kv.zero_lo = 0;
                    row0 = NPR + b * 8 + (lane & 7); valid = (lane & 15) < 8; niter = (wave == 0) ? 1 : 0;
                }
                attn_load_kv<128>(lds, kv, tid);
                __syncthreads();
                for (int t = 0; t < niter; ++t) {
                    asm volatile("" ::: "memory");
                    const int row = row0 + 16 * t;
                    bf16x8 qf[4]; attn_loadq<128>(qf, Z + (size_t)row * NIN + QMOFF + h * 128, lane);
                    attn16<128, false>(lds, qf, MIX + (size_t)row * DM + TW + h * 128, valid, 0, true, 0.f, 0, 15, lane);
                }
                __syncthreads();
            }

            if (li == 0) {
                const float* cw = p.in[I_CW];
                for (int item = bx * NTHREADS + tid; item < 1056 * 192; item += G * NTHREADS) {
                    const int run = item / 192, ch0 = (item % 192) * 8;
                    float w0[8], w1[8], w2[8], pm2[8], pm1[8];
#pragma unroll
                    for (int i = 0; i < 8; ++i) { w0[i] = cw[ch0 + i]; w1[i] = cw[TW + ch0 + i]; w2[i] = cw[2 * TW + ch0 + i]; pm2[i] = 0.f; pm1[i] = 0.f; }
                    int row0; bool last; float* so;
                    if (run < 1024) { const int b = run >> 8, t0 = (run & 255) * 8; row0 = b * 2048 + t0; last = (run & 255) == 255; so = out + OUT_CP + (size_t)(b * 2) * TW + ch0;
                        if (t0 > 0) {
                            const bf16* z2 = Z + (size_t)(row0 - 2) * NIN0 + ch0; const bf16* z1 = z2 + NIN0;
                            const u32x4 c2 = *(const u32x4*)(z2 + TW), u2 = *(const u32x4*)(z2 + 2 * TW), c1 = *(const u32x4*)(z1 + TW), u1 = *(const u32x4*)(z1 + 2 * TW);
#pragma unroll
                            for (int i = 0; i < 4; ++i) { pm2[2 * i] = bf_lo(c2[i]) * bf_lo(u2[i]); pm2[2 * i + 1] = bf_hi(c2[i]) * bf_hi(u2[i]); pm1[2 * i] = bf_lo(c1[i]) * bf_lo(u1[i]); pm1[2 * i + 1] = bf_hi(c1[i]) * bf_hi(u1[i]); }
                        }
                    } else { const int b = run - 1024; row0 = NPR + b * 8; last = true; so = out + OUT_CS + (size_t)(b * 2) * TW + ch0;
                        const float* sc = p.in[I_SCONV] + (size_t)(b * 2) * TW + ch0;
#pragma unroll
                        for (int i = 0; i < 8; ++i) { pm2[i] = sc[i]; pm1[i] = sc[TW + i]; }
                    }
#pragma unroll
                    for (int t = 0; t < 8; ++t) {
                        const bf16* zr = Z + (size_t)(row0 + t) * NIN0 + ch0;
                        const u32x4 bb = *(const u32x4*)zr, cc = *(const u32x4*)(zr + TW), uu = *(const u32x4*)(zr + 2 * TW);
                        float tok[8];
#pragma unroll
                        for (int i = 0; i < 4; ++i) {
                            const float cu0 = bf_lo(cc[i]) * bf_lo(uu[i]), cu1 = bf_hi(cc[i]) * bf_hi(uu[i]);
                            tok[2 * i] = bf_lo(bb[i]) * (w0[2 * i] * pm2[2 * i] + w1[2 * i] * pm1[2 * i] + w2[2 * i] * cu0);
                            tok[2 * i + 1] = bf_hi(bb[i]) * (w0[2 * i + 1] * pm2[2 * i + 1] + w1[2 * i + 1] * pm1[2 * i + 1] + w2[2 * i + 1] * cu1);
                            pm2[2 * i] = pm1[2 * i]; pm2[2 * i + 1] = pm1[2 * i + 1]; pm1[2 * i] = cu0; pm1[2 * i + 1] = cu1;
                        }
                        u32x4 w; w.x = pk2(tok[0], tok[1]); w.y = pk2(tok[2], tok[3]); w.z = pk2(tok[4], tok[5]); w.w = pk2(tok[6], tok[7]);
                        *(u32x4*)(MIX + (size_t)(row0 + t) * DM + ch0) = w;
                    }
                    if (last) {
#pragma unroll
                        for (int i = 0; i < 8; ++i) { so[i] = pm2[i]; so[TW + i] = pm1[i]; }
                    }
                }

            } else {
                const float* sinks = p.in[I_SINKS];
                for (int u = bx; u < 384; u += G) {
                    KVDesc kv; int b, kh, blk = 0; const bool isp = u < 256;
                    if (isp) { b = u >> 6; blk = (u >> 2) & 15; kh = u & 3;
                        kv.kb = Z + ((long)(b * 2048 + (blk - 1) * 128)) * NIN1 + TW + 64 * kh; kv.vb = kv.kb + 256; kv.kf = nullptr; kv.vf = nullptr; kv.strideb = NIN1; kv.stridef = 0; kv.n_f32 = 0; kv.n_b16 = 256; kv.zero_lo = blk == 0 ? 128 : 0;
                    } else { const int s = u - 256; b = s >> 2; kh = s & 3;
                        kv.kf = p.in[I_CWK] + (size_t)(b * 128) * 256 + kh * 64; kv.vf = p.in[I_CWV] + (size_t)(b * 128) * 256 + kh * 64; kv.stridef = 256; kv.n_f32 = 128;
                        kv.kb = Z + (size_t)(NPR + b * 8) * NIN1 + TW + 64 * kh; kv.vb = kv.kb + 256; kv.strideb = NIN1; kv.n_b16 = 8; kv.zero_lo = 0;
                    }
                    attn_load_kv<64>(lds, kv, tid);
                    __syncthreads();
                    const int niter = isp ? 6 : (wave < 3 ? 1 : 0);
                    const int qi = isp ? wave * 16 + (lane & 15) : (lane & 7);
                    const int row = isp ? b * 2048 + blk * 128 + qi : NPR + b * 8 + qi;
                    const int hq0 = isp ? 6 * kh : 6 * kh + 2 * wave + ((lane & 15) >> 3);
                    const int kt_lo = isp ? (blk == 0 && wave < 8 ? 8 : wave) : 0, kt_hi = isp ? wave + 8 : 8;
                    for (int it = 0; it < niter; ++it) {
                        asm volatile("" ::: "memory");
                        const int hq = hq0 + it;
                        bf16x8 qc[2]; attn_loadq<64>(qc, Z + (size_t)row * NIN1 + hq * 64, lane);
                        attn16<64, true>(lds, qc, MIX + (size_t)row * DM + hq * 64, true, qi, !isp || blk > 0, sinks[hq] * 1.4426950408889634f, kt_lo, kt_hi, lane);
                    }
                    __syncthreads();
                }

                for (int e = bx * NTHREADS + tid; e < 4 * 128 * 128; e += G * NTHREADS) {
                    const int c = (e & 127) * 4, j = (e >> 7) & 127, b = e >> 14;
                    const u32x2 v = *(const u32x2*)(Z + (size_t)(b * 2048 + 1920 + j) * NIN1 + TW + c);
                    *(f32x4*)(out + (c < 256 ? OUT_WKP : OUT_WVP) + (size_t)(b * 128 + j) * 256 + (c & 255)) = (f32x4){bf_lo(v.x), bf_hi(v.x), bf_lo(v.y), bf_hi(v.y)};
                }
#pragma unroll 4
                for (int e = bx * NTHREADS + tid; e < 32 * 128 * 128; e += G * NTHREADS) {
                    const int c = (e & 127) * 4, j = (e >> 7) & 127, b = e >> 14; f32x4 v;
                    if (j < 120) v = *(const f32x4*)((c < 256 ? p.in[I_CWK] : p.in[I_CWV]) + (size_t)(b * 128 + 8 + j) * 256 + (c & 255));
                    else { const u32x2 w = *(const u32x2*)(Z + (size_t)(NPR + b * 8 + j - 120) * NIN1 + TW + c); v = (f32x4){bf_lo(w.x), bf_hi(w.x), bf_lo(w.y), bf_hi(w.y)}; }
                    *(f32x4*)(out + (c < 256 ? OUT_WKS : OUT_WVS) + (size_t)(b * 128 + j) * 256 + (c & 255)) = v;
                }
            }
        }
        xcd_barrier(xbar);
        {
            pg8::Gemm g{MIX, WOUT + (size_t)li * DM * DM, MT, DM, DM}; pg8::TailOrder S; S.init(G, bx, DM, SNT_OUT);
            pg8::EpiResid E{nullptr, nullptr, PART, H, RSP, true};
            pg8::gemm_phase<pg8::EpiResid, pg8::TailOrder, true, true>(lds, g, S, E);
        }

        xcd_barrier(xbar);
        { PHASE_IDS(); fixup_phase(X, PART, NSL_OUT, H, RS + (size_t)(2 * li) * MT, RSP, (LAS float*)lds, bx, G, tid); }
        xcd_barrier(xbar);
        {
            pg8::Gemm g{H, WGU + (size_t)li * NGU * DM, MT, NGU, DM}; pg8::StaticOrder S; S.init(MT, NGU, G, bx, DM);
            pg8::EpiSwiglu E{ZA, RS + (size_t)(2 * li) * MT};
            pg8::gemm_phase<pg8::EpiSwiglu, pg8::StaticOrder, true, true>(lds, g, S, E);
        }
        if (defer && li == 0 && bx >= 172) { PHASE_IDS(); CONVERT_SIMPLE(DEF0 + DEF_A + (bx - 172) * 8 + wave, 84 * 8, DQ, DEF0 + DEF_A + DEF_B); }

        xcd_barrier(xbar);
        {
            pg8::Gemm g{ZA, WDN + (size_t)li * DM * FF, MT, DM, FF}; pg8::TailOrder S; S.init(G, bx, FF, SNT_DN);
            pg8::EpiResid E{nullptr, nullptr, PART, H, RSP, true};
            pg8::gemm_phase<pg8::EpiResid, pg8::TailOrder, true, true>(lds, g, S, E);
        }

        xcd_barrier(xbar);
        if (li == 0) {
            { PHASE_IDS(); fixup_phase(X, PART, NSL_DN, H, RS + (size_t)MT, RSP, (LAS float*)lds, bx, G, tid); }
            xcd_barrier(xbar);
        }
    }
    { PHASE_IDS(); final_sample_rows(X, PART, NSL_DN, p.in[I_NFINAL], (LAS float*)lds, bx, G, tid); for (int m = gw; m < NPR; m += 4 * NGW) rms_rows_from_bf16<4>(H, m, NGW, NPR, p.in[I_NFINAL], X, lane); }
}

extern "C" void kernel_launch(void* const* d_in, const int* in_sizes, int n_in, void* d_out, int out_size, void* d_ws, size_t ws_size, hipStream_t stream) {
    static int grid = 0;
    if (grid == 0) {
        if (n_in != 22 || (size_t)out_size != OUT_END || ws_size < WS_END) { fprintf(stderr, "kernel_launch: unexpected shapes (n_in %d out %d ws %zu)\n", n_in, out_size, ws_size); grid = -1; return; }
        int dev = 0, cus = 0, per_cu = 0;
        if (hipGetDevice(&dev) != hipSuccess || hipDeviceGetAttribute(&cus, hipDeviceAttributeMultiprocessorCount, dev) != hipSuccess) { grid = -1; return; }
        if (hipFuncSetAttribute((const void*)fwd_megakernel, hipFuncAttributeMaxDynamicSharedMemorySize, LDS_BYTES) != hipSuccess) { fprintf(stderr, "kernel_launch: hipFuncSetAttribute failed\n"); grid = -1; return; }
        if (hipOccupancyMaxActiveBlocksPerMultiprocessor(&per_cu, (const void*)fwd_megakernel, NTHREADS, LDS_BYTES) != hipSuccess || per_cu < 1) { fprintf(stderr, "kernel_launch: occupancy query says %d\n", per_cu); per_cu = 1; }
        (void)hipGetLastError();
        grid = cus * 1;
    }
    if (grid < 0) return;
    Params prm{};
    for (int i = 0; i < 22; ++i) prm.in[i] = (const float*)d_in[i];
    prm.out = (float*)d_out; prm.ws = (unsigned char*)d_ws;
    void* args[] = {&prm};
    hipError_t e = hipLaunchCooperativeKernel((const void*)fwd_megakernel, dim3(grid), dim3(NTHREADS), args, LDS_BYTES, stream);
    if (e != hipSuccess) fprintf(stderr, "kernel_launch: cooperative launch failed: %s (grid %d)\n", hipGetErrorString(e), grid);
}
```
